# Optimizing an MI355X kernel written in HIP

```python
import math
import jax, jax.numpy as jnp
from jax import lax
import numpy as np

D_MODEL = 2048
BATCH = 4
SEQ = 2048
DEPTH = 4
DEC_BATCH = 32
DEC_SEQ = 1
PAST_LEN = 16384
PAGE_SIZE = 128

HEAD_DIM = D_MODEL // 16
N_LIN_HEADS = 8
LIN_WIDTH = N_LIN_HEADS * HEAD_DIM
N_ATT_HEADS = 8
N_KV_HEADS = 2
GROUP = N_ATT_HEADS // N_KV_HEADS
ATT_WIDTH = N_ATT_HEADS * HEAD_DIM
KV_WIDTH = N_KV_HEADS * HEAD_DIM
MIX_WIDTH = LIN_WIDTH + ATT_WIDTH
WINDOW = 128
D_FF = ((8 * D_MODEL // 3 + 255) // 256) * 256
CHUNK = 64
IN_WIDTH = 4 * LIN_WIDTH + ATT_WIDTH + 2 * KV_WIDTH
SPLIT_IDX = (LIN_WIDTH, 2 * LIN_WIDTH, 3 * LIN_WIDTH, 4 * LIN_WIDTH,
             4 * LIN_WIDTH + ATT_WIDTH, 4 * LIN_WIDTH + ATT_WIDTH + KV_WIDTH)
EPS = 1e-6
ATT_SCALE = HEAD_DIM ** -0.5

kernel_name = "hymba_hgrn2_swa_sink_adaln_decoder_step"


def _rms(x, g):
    xf = x.astype(jnp.float32)
    y = xf * lax.rsqrt(jnp.mean(xf * xf, axis=-1, keepdims=True) + EPS)
    return (y * g.astype(jnp.float32)).astype(x.dtype)


def _hgrn2_chunked(q, k, v, logf, s0):
    B, T, H, _ = q.shape
    C = math.gcd(T, CHUNK)
    n = T // C

    def to_chunks(a):
        return a.reshape(B, n, C, H, a.shape[-1]).transpose(1, 0, 3, 2, 4)

    qc, kc, vc, gc = to_chunks(q), to_chunks(k), to_chunks(v), to_chunks(logf)
    causal = jnp.tril(jnp.ones((C, C), dtype=bool))

    def step(S, inp):
        qi, ki, vi, gi = inp
        b = jnp.cumsum(gi, axis=-2)
        o_inter = jnp.einsum('bhtk,bhkv->bhtv', qi * jnp.exp(b), S)
        diff = b[:, :, :, None, :] - b[:, :, None, :, :]
        decay = jnp.exp(jnp.where(causal[:, :, None], diff, -jnp.inf))
        A = jnp.einsum('bhtk,bhtsk,bhsk->bhts', qi, decay, ki)
        o_intra = jnp.einsum('bhts,bhsv->bhtv', A, vi)
        b_end = b[:, :, -1:, :]
        S_new = S * jnp.exp(b_end[:, :, 0, :, None]) + jnp.einsum(
            'bhsk,bhsv->bhkv', ki * jnp.exp(b_end - b), vi)
        return S_new, o_inter + o_intra

    S_T, o = lax.scan(step, s0.astype(jnp.float32), (qc, kc, vc, gc))
    o = o.transpose(1, 0, 3, 2, 4).reshape(B, T, H, v.shape[-1])
    return o.astype(v.dtype), S_T.astype(s0.dtype)


def _sink_attention(q, k, v, dist, valid, sinks):
    slopes = 2.0 ** (-8.0 * jnp.arange(1, N_ATT_HEADS + 1) / N_ATT_HEADS)
    slopes = slopes.reshape(N_KV_HEADS, GROUP)[None, None, :, :, None, None]
    s = jnp.einsum('bnqhgd,bnshd->bnhgqs', q, k).astype(jnp.float32) * ATT_SCALE
    s = s - slopes * dist[None, :, None, None, :, :].astype(jnp.float32)
    s = jnp.where(valid[None, :, None, None, :, :], s, -jnp.inf)
    sink = jnp.broadcast_to(
        sinks.astype(jnp.float32).reshape(N_KV_HEADS, GROUP)[None, None, :, :, None, None],
        s.shape[:-1] + (1,))
    p = jax.nn.softmax(jnp.concatenate([s, sink], axis=-1), axis=-1)[..., :-1]
    return jnp.einsum('bnhgqs,bnshd->bnqhgd', p.astype(v.dtype), v)


def _layer(x, c, s0, k_past, v_past, lb, w_ada, b_ada, norm_mix, w_in, q_norm, k_norm,
           sinks, g_norm, w_out, norm_ffn, w_gate, w_up, w_down):
    B, T, _ = x.shape
    mod = jnp.einsum('bd,de->be', jax.nn.silu(c), w_ada) + b_ada
    sh1, sc1, gt1, sh2, sc2, gt2 = jnp.split(mod[:, None, :], 6, axis=-1)

    h = _rms(x, norm_mix) * (1.0 + sc1) + sh1
    proj = jnp.einsum('btd,de->bte', h, w_in)
    q_l, f_l, i_l, g_l, q_a, k_a, v_a = jnp.split(proj, SPLIT_IDX, axis=-1)

    def heads(a, n):
        return a.reshape(B, T, n, HEAD_DIM)

    ql = jax.nn.silu(heads(q_l, N_LIN_HEADS))
    f_raw = heads(f_l, N_LIN_HEADS).astype(jnp.float32)
    lbh = lb.reshape(N_LIN_HEADS, HEAD_DIM).astype(jnp.float32)
    logf = jnp.logaddexp(jnp.log(lbh), jnp.log1p(-lbh) + jax.nn.log_sigmoid(f_raw))
    kl = -jnp.expm1(logf)
    o_l, s_new = _hgrn2_chunked(ql, kl, heads(i_l, N_LIN_HEADS), logf, s0)
    o_l = _rms(o_l, g_norm) * jax.nn.silu(heads(g_l, N_LIN_HEADS))

    qa = _rms(heads(q_a, N_ATT_HEADS), q_norm)
    ka = _rms(heads(k_a, N_KV_HEADS), k_norm)
    va = heads(v_a, N_KV_HEADS)
    if k_past is None:
        nb = T // WINDOW
        qb = qa.reshape(B, nb, WINDOW, N_KV_HEADS, GROUP, HEAD_DIM)
        kb = ka.reshape(B, nb, WINDOW, N_KV_HEADS, HEAD_DIM)
        vb = va.reshape(B, nb, WINDOW, N_KV_HEADS, HEAD_DIM)
        padw = ((0, 0), (1, 0), (0, 0), (0, 0), (0, 0))
        kk = jnp.concatenate([jnp.pad(kb, padw)[:, :-1], kb], axis=2)
        vv = jnp.concatenate([jnp.pad(vb, padw)[:, :-1], vb], axis=2)
        kpos = jnp.arange(2 * WINDOW)
        dist = (WINDOW + jnp.arange(WINDOW))[:, None] - kpos[None, :]
        valid = ((dist >= 0) & (dist <= WINDOW))[None] & (
            (jnp.arange(nb)[:, None, None] > 0) | (kpos[None, None, :] >= WINDOW))
        dist = dist[None]
        k_new, v_new = ka[:, -WINDOW:], va[:, -WINDOW:]
    else:
        qb = qa.reshape(B, 1, T, N_KV_HEADS, GROUP, HEAD_DIM)
        kcat = jnp.concatenate([k_past, ka], axis=1)
        vcat = jnp.concatenate([v_past, va], axis=1)
        kk, vv = kcat[:, None], vcat[:, None]
        dist = (WINDOW + jnp.arange(T))[:, None] - jnp.arange(WINDOW + T)[None, :]
        valid = ((dist >= 0) & (dist <= WINDOW))[None]
        dist = dist[None]
        k_new, v_new = kcat[:, -WINDOW:], vcat[:, -WINDOW:]
    o_a = _sink_attention(qb, kk, vv, dist, valid, sinks).reshape(B, T, ATT_WIDTH)

    mixed = jnp.concatenate([o_l.reshape(B, T, LIN_WIDTH), o_a], axis=-1)
    x = x + gt1 * jnp.einsum('bte,ed->btd', mixed, w_out)

    h2 = _rms(x, norm_ffn) * (1.0 + sc2) + sh2
    ff = jax.nn.silu(jnp.einsum('btd,df->btf', h2, w_gate)) * jnp.einsum('btd,df->btf', h2, w_up)
    x = x + gt2 * jnp.einsum('btf,fd->btd', ff, w_down)
    return x, s_new, k_new, v_new


def setup_inputs(seed: int = 0) -> dict:
    key = jax.random.key(seed)
    ks = jax.random.split(key, 24)

    def nrm(k, shape, s):
        return jax.random.normal(k, shape, jnp.float32) * s

    return {
        "x_prompt": nrm(ks[0], (BATCH, SEQ, D_MODEL), 1.0),
        "x_sample": nrm(ks[1], (DEC_BATCH, DEC_SEQ, D_MODEL), 1.0),
        "cache_k": nrm(ks[2], (DEPTH, DEC_BATCH, WINDOW, N_KV_HEADS, HEAD_DIM), 1.0),
        "cache_v": nrm(ks[3], (DEPTH, DEC_BATCH, WINDOW, N_KV_HEADS, HEAD_DIM), 1.0),
        "state_hgrn": nrm(ks[4], (DEPTH, DEC_BATCH, N_LIN_HEADS, HEAD_DIM, HEAD_DIM), 1.0),
        "c_prompt": nrm(ks[5], (BATCH, D_MODEL), 1.0),
        "c_sample": nrm(ks[6], (DEC_BATCH, D_MODEL), 1.0),
        "lower_bounds": nrm(ks[7], (DEPTH, LIN_WIDTH), 1.0),
        "w_ada": nrm(ks[8], (DEPTH, D_MODEL, 6 * D_MODEL), 0.5 * D_MODEL ** -0.5),
        "b_ada": nrm(ks[9], (DEPTH, 6 * D_MODEL), 0.02),
        "norm_mix": 1.0 + nrm(ks[10], (DEPTH, D_MODEL), 0.01),
        "w_in": nrm(ks[11], (DEPTH, D_MODEL, IN_WIDTH), D_MODEL ** -0.5),
        "q_norm": 1.0 + nrm(ks[12], (DEPTH, HEAD_DIM), 0.01),
        "k_norm": 1.0 + nrm(ks[13], (DEPTH, HEAD_DIM), 0.01),
        "attn_sinks": nrm(ks[14], (DEPTH, N_ATT_HEADS), 0.5),
        "g_norm": 1.0 + nrm(ks[15], (DEPTH, HEAD_DIM), 0.01),
        "w_out": nrm(ks[16], (DEPTH, MIX_WIDTH, D_MODEL), MIX_WIDTH ** -0.5),
        "norm_ffn": 1.0 + nrm(ks[17], (DEPTH, D_MODEL), 0.01),
        "w_gate": nrm(ks[18], (DEPTH, D_MODEL, D_FF), D_MODEL ** -0.5),
        "w_up": nrm(ks[19], (DEPTH, D_MODEL, D_FF), D_MODEL ** -0.5),
        "w_down": nrm(ks[20], (DEPTH, D_FF, D_MODEL), D_FF ** -0.5),
    }


def reference(x_prompt, x_sample, cache_k, cache_v, state_hgrn, c_prompt, c_sample,
              lower_bounds, w_ada, b_ada, norm_mix, w_in, q_norm, k_norm, attn_sinks,
              g_norm, w_out, norm_ffn, w_gate, w_up, w_down):
    lb_all = jnp.cumsum(jax.nn.softmax(lower_bounds.astype(jnp.float32), axis=0), axis=0)
    lb_all = lb_all - lb_all[:1]
    s0_prompt = jnp.zeros((x_prompt.shape[0], N_LIN_HEADS, HEAD_DIM, HEAD_DIM), state_hgrn.dtype)
    yp, ys = x_prompt, x_sample
    pk, pv, ps, sk, sv, ss = [], [], [], [], [], []
    for l in range(DEPTH):
        params = (lb_all[l], w_ada[l], b_ada[l], norm_mix[l], w_in[l], q_norm[l], k_norm[l],
                  attn_sinks[l], g_norm[l], w_out[l], norm_ffn[l], w_gate[l], w_up[l], w_down[l])
        yp, s_p, k_p, v_p = _layer(yp, c_prompt, s0_prompt, None, None, *params)
        ys, s_s, k_s, v_s = _layer(ys, c_sample, state_hgrn[l], cache_k[l], cache_v[l], *params)
        pk.append(k_p); pv.append(v_p); ps.append(s_p)
        sk.append(k_s); sv.append(v_s); ss.append(s_s)
    return (yp, ys, jnp.stack(pk), jnp.stack(pv), jnp.stack(ps),
            jnp.stack(sk), jnp.stack(sv), jnp.stack(ss))
```

```cpp
#include <hip/hip_runtime.h>
#include <cstdio>
#include <cstdint>
namespace pg8 {
#define PG8_LAS __attribute__((address_space(3)))
typedef unsigned short bf16_t;
typedef short bf16x8 __attribute__((ext_vector_type(8)));
typedef float f32x4 __attribute__((ext_vector_type(4)));
typedef unsigned u32x4 __attribute__((ext_vector_type(4)));
constexpr int BM = 256, BK = 64, HALF = 128, HTB = HALF * BK * 2  , STAGE_BYTES = 8 * HTB, NXCD = 8, WGM = 8;

__host__ __device__ __forceinline__ int lds_byte(int r, int c) { const int st = (r >> 4) * 2 + (c >> 5), rr = r & 15, cc = c & 31, ob = rr * 64 + cc * 2; return st * 1024 + (ob ^ (((ob >> 9) & 1) << 5)); }
__host__ __device__ __forceinline__ void stage_rc(int b, int& R, int& C) { const int st = b / 1024, sb = b % 1024, swz = sb ^ (((sb >> 9) & 1) << 5); R = (st >> 1) * 16 + swz / 64; C = (st & 1) * 32 + (swz % 64) / 2; }
__host__ __device__ __forceinline__ int perm32(int rho) { const int n = rho >> 4, i = rho & 15; return 8 * (i >> 2) + 4 * n + (i & 3); }

struct Unit { int pm, pn; };
struct Gemm { const bf16_t* A; const bf16_t* Bt; int M, N, K; };

struct StaticOrder {
    int nM, nN, nwg, G, c;
    __host__ __device__ void init(int M, int N, int G_, int c_) { nM = M / BM; nN = N / BM; nwg = nM * nN; G = G_; c = c_; }
    __host__ __device__ bool next(int i, Unit& u) const {
        const long L = (long)i * G + c; if (L >= nwg) return false;
        int wgid = (int)L; { const int q = nwg / NXCD, r = nwg % NXCD, xcd = wgid % NXCD, off = wgid / NXCD; wgid = (xcd < r ? xcd * (q + 1) : r * (q + 1) + (xcd - r) * q) + off; }
        const int nig = WGM * nN, gid = wgid / nig, fm = gid * WGM, gsz = (nM - fm) < WGM ? (nM - fm) : WGM;
        u.pm = fm + ((wgid % nig) % gsz); u.pn = (wgid % nig) / gsz; return true;
    }
    __device__ __forceinline__ void a_ready(const Unit&) const {}
    __device__ __forceinline__ void done(const Unit&) const {}
};

__device__ __forceinline__ unsigned cvt_pk_bf16(float lo, float hi) { unsigned r; asm volatile("v_cvt_pk_bf16_f32 %0, %1, %2" : "=v"(r) : "v"(lo), "v"(hi)); return r; }
typedef float f32x2 __attribute__((ext_vector_type(2)));
__device__ __forceinline__ int mod_row(int r) { return r < 8192 ? (r >> 11) : (r < 8224 ? r - 8192 + 4 : 35); }
struct EpiF32 {
    static constexpr bool PERM = false, AFTER_DRAIN = false;
    float* O; int ldc;
    __device__ __forceinline__ void operator()(const f32x4 (&acc)[2][2][4][2], const Unit& u, int wr, int wc, int fr, int fq) const {
        const int row0 = u.pm * BM + wr * 64 + fr, col0 = u.pn * BM + wc * 32 + 4 * fq;
#pragma unroll
        for (int ai = 0; ai < 2; ++ai)
#pragma unroll
            for (int m = 0; m < 4; ++m) { float* rowp = O + (size_t)(row0 + ai * HALF + m * 16) * ldc + col0;
#pragma unroll
                for (int bj = 0; bj < 2; ++bj)
#pragma unroll
                    for (int n = 0; n < 2; ++n) *(f32x4*)(rowp + bj * HALF + n * 16) = acc[ai][bj][m][n]; }
    }
};
struct EpiResid {
    static constexpr bool PERM = false, AFTER_DRAIN = false;
    const float* Xin; float* Xout; float* Xout2; const float* gate; int ldg;
    __device__ __forceinline__ void operator()(const f32x4 (&acc)[2][2][4][2], const Unit& u, int wr, int wc, int fr, int fq) const {
        const int row0 = u.pm * BM + wr * 64 + fr, col0 = u.pn * BM + wc * 32 + 4 * fq;
#pragma unroll
        for (int ai = 0; ai < 2; ++ai)
#pragma unroll
            for (int m = 0; m < 4; ++m) { const int r = row0 + ai * HALF + m * 16;
                if (r < 8224) { const float* gp = gate + (size_t)mod_row(r) * ldg + col0; const size_t off = (size_t)r * 2048 + col0;
#pragma unroll
                for (int bj = 0; bj < 2; ++bj)
#pragma unroll
                    for (int n = 0; n < 2; ++n) { const f32x4 g = *(const f32x4*)(gp + bj * HALF + n * 16); const f32x4 x = *(const f32x4*)(Xin + off + bj * HALF + n * 16);
                        const f32x4 o = x + g * acc[ai][bj][m][n]; *(f32x4*)(Xout + off + bj * HALF + n * 16) = o; if (Xout2) *(f32x4*)(Xout2 + off + bj * HALF + n * 16) = o; } } }
    }
};
struct EpiSwiglu {
    static constexpr bool PERM = true, AFTER_DRAIN = false;
    bf16_t* O; int ldc;
    __device__ __forceinline__ void operator()(const f32x4 (&acc)[2][2][4][2], const Unit& u, int wr, int wc, int fr, int fq) const {
        const int row0 = u.pm * BM + wr * 64 + fr, col0 = u.pn * HALF + wc * 32 + 8 * fq;
#pragma unroll
        for (int ai = 0; ai < 2; ++ai)
#pragma unroll
            for (int m = 0; m < 4; ++m) { bf16_t* rowp = O + (size_t)(row0 + ai * HALF + m * 16) * ldc + col0;
                float v[8];
#pragma unroll
                for (int n = 0; n < 2; ++n)
#pragma unroll
                    for (int j = 0; j < 4; ++j) { const float g = acc[ai][0][m][n][j], up = acc[ai][1][m][n][j]; v[n * 4 + j] = g / (1.0f + __expf(-g)) * up; }
                u32x4 w; w.x = cvt_pk_bf16(v[0], v[1]); w.y = cvt_pk_bf16(v[2], v[3]); w.z = cvt_pk_bf16(v[4], v[5]); w.w = cvt_pk_bf16(v[6], v[7]);
                *(u32x4*)rowp = w; }
    }
};
template <class Epi, class Sched, bool ALIGN_EPI = false, bool SP2 = false>
__device__ __forceinline__ void gemm_phase(PG8_LAS unsigned char* lds, const Gemm g, const Sched& S, const Epi& E) {
    const int tid = threadIdx.x, wid = __builtin_amdgcn_readfirstlane(tid >> 6), lane = tid & 63, wr = wid >> 2, wc = wid & 3, fr = lane & 15, fq = lane >> 4;
    const int K = g.K, nt = K / BK;
    unsigned voffA[2], voffB[2];
#pragma unroll
    for (int i = 0; i < 2; ++i) { int R, C; stage_rc(tid * 16 + i * 8192, R, C); const int Rb = Epi::PERM ? ((R & ~31) + perm32(R & 31)) : R;
        voffA[i] = (unsigned)(R * K + C) * 2u; voffB[i] = (unsigned)(Rb * K + C) * 2u; }
    const size_t kstep = (size_t)(BK * 2);
    const size_t hstep = (size_t)HALF * K * 2;
    const size_t tstep = 2 * hstep;
    const unsigned ldsw = (unsigned)wid * 1024u;
    const int aoff = lds_byte(wr * 64 + fr, fq * 8), boff = lds_byte(wc * 32 + fr, fq * 8);
#define PG8_SA(b, h) (((b) * 2 + (h)) * HTB)
#define PG8_SB(b, h) ((4 + (b) * 2 + (h)) * HTB)
#define PG8_STAGE(bufoff, gbase, voff) do { _Pragma("unroll") for (int _i = 0; _i < 2; ++_i) \
        __builtin_amdgcn_global_load_lds((const unsigned*)((const char*)(gbase) + (voff)[_i]), (PG8_LAS unsigned*)(lds + (bufoff) + ldsw + _i * 8192), 16, 0, 0); } while (0)
#define PG8_LDA(dst, b, h) do { _Pragma("unroll") for (int m = 0; m < 4; ++m) _Pragma("unroll") for (int k = 0; k < 2; ++k) dst[m][k] = *(const PG8_LAS bf16x8*)(lds + PG8_SA(b, h) + aoff + m * 2048 + k * 1024); } while (0)
#define PG8_LDB(dst, b, h) do { _Pragma("unroll") for (int n = 0; n < 2; ++n) _Pragma("unroll") for (int k = 0; k < 2; ++k) dst[n][k] = *(const PG8_LAS bf16x8*)(lds + PG8_SB(b, h) + boff + n * 2048 + k * 1024); } while (0)
#define PG8_MMA(ai, bj, At, Bt) do { __builtin_amdgcn_s_setprio(1); _Pragma("unroll") for (int m = 0; m < 4; ++m) _Pragma("unroll") for (int n = 0; n < 2; ++n) _Pragma("unroll") for (int k = 0; k < 2; ++k) \
        acc[ai][bj][m][n] = __builtin_amdgcn_mfma_f32_16x16x32_bf16(Bt[n][k], At[m][k], acc[ai][bj][m][n], 0, 0, 0); __builtin_amdgcn_s_setprio(0); } while (0)
#define PG8_WAIT_V(n) asm volatile("s_waitcnt vmcnt(" #n ")" ::: "memory")
#define PG8_WAIT_L(n) asm volatile("s_waitcnt lgkmcnt(" #n ")" ::: "memory")
#define PG8_BAR __builtin_amdgcn_s_barrier()
#define PG8_SCHED __builtin_amdgcn_sched_barrier(0)
    Unit cur, nxt; int ui = 0;
    if (!S.next(0, cur)) return;
    f32x4 acc[2][2][4][2];
#pragma unroll
    for (int a = 0; a < 2; ++a)
#pragma unroll
        for (int b = 0; b < 2; ++b)
#pragma unroll
            for (int m = 0; m < 4; ++m)
#pragma unroll
                for (int n = 0; n < 2; ++n) acc[a][b][m][n] = (f32x4){0.f, 0.f, 0.f, 0.f};
    bf16x8 At[4][2], B0[2][2], B1[2][2];
    const char* cA = (const char*)g.A + (size_t)cur.pm * tstep; const char* cB = (const char*)g.Bt + (size_t)cur.pn * tstep;
    S.a_ready(cur);
    if constexpr (SP2) {
        PG8_STAGE(PG8_SB(0, 0), cB, voffB); PG8_STAGE(PG8_SB(0, 1), cB + hstep, voffB); PG8_STAGE(PG8_SA(0, 0), cA, voffA); PG8_STAGE(PG8_SA(0, 1), cA + hstep, voffA);
        if (wr == 1) PG8_BAR;
        PG8_WAIT_V(2); PG8_BAR;
        PG8_STAGE(PG8_SB(1, 0), cB + kstep, voffB); PG8_STAGE(PG8_SA(1, 0), cA + kstep, voffA); PG8_STAGE(PG8_SB(1, 1), cB + hstep + kstep, voffB);
        PG8_WAIT_V(6); PG8_BAR;
    } else {
        PG8_STAGE(PG8_SB(0, 0), cB, voffB); PG8_STAGE(PG8_SA(0, 0), cA, voffA); PG8_STAGE(PG8_SB(0, 1), cB + hstep, voffB); PG8_STAGE(PG8_SA(0, 1), cA + hstep, voffA);
        if (wr == 1) PG8_BAR;
        PG8_WAIT_V(4); PG8_BAR;
        PG8_STAGE(PG8_SB(1, 0), cB + kstep, voffB); PG8_STAGE(PG8_SA(1, 0), cA + kstep, voffA); PG8_STAGE(PG8_SB(1, 1), cB + hstep + kstep, voffB);
        PG8_WAIT_V(6); PG8_BAR;
    }
    for (;;) {
        const bool has_next = S.next(ui + 1, nxt);
        const char* nA = has_next ? (const char*)g.A + (size_t)nxt.pm * tstep : cA; const char* nB = has_next ? (const char*)g.Bt + (size_t)nxt.pn * tstep : cB;
        for (int t = 0; t < nt; t += 2) {
            const bool last = (t == nt - 2);
            const char* a1 = cA + (size_t)(t + 1) * kstep;
            const char* a2 = last ? nA : cA + (size_t)(t + 2) * kstep; const char* b2 = last ? nB : cB + (size_t)(t + 2) * kstep;
            const char* a3 = a2 + kstep; const char* b3 = b2 + kstep;
            if (last && has_next) S.a_ready(nxt);
            if constexpr (SP2) {
            PG8_LDB(B0, 0, 0); PG8_LDB(B1, 0, 1); PG8_SCHED; PG8_LDA(At, 0, 0); PG8_STAGE(PG8_SA(1, 1), a1 + hstep, voffA);
            PG8_WAIT_V(8); PG8_WAIT_L(0); PG8_BAR; PG8_MMA(0, 0, At, B0); PG8_MMA(0, 1, At, B1); PG8_BAR; PG8_SCHED;
            PG8_LDA(At, 0, 1); PG8_STAGE(PG8_SB(0, 0), b2, voffB); PG8_STAGE(PG8_SB(0, 1), b2 + hstep, voffB); PG8_STAGE(PG8_SA(0, 0), a2, voffA);
            PG8_WAIT_V(8); PG8_WAIT_L(0); PG8_BAR; PG8_MMA(1, 0, At, B0); PG8_MMA(1, 1, At, B1); PG8_BAR; PG8_SCHED;
            PG8_LDB(B0, 1, 0); PG8_LDB(B1, 1, 1); PG8_SCHED; PG8_LDA(At, 1, 0); PG8_STAGE(PG8_SA(0, 1), a2 + hstep, voffA);
            PG8_WAIT_V(8); PG8_WAIT_L(0); PG8_BAR; PG8_MMA(0, 0, At, B0); PG8_MMA(0, 1, At, B1); PG8_BAR; PG8_SCHED;
            PG8_LDA(At, 1, 1); PG8_STAGE(PG8_SB(1, 0), b3, voffB); PG8_STAGE(PG8_SB(1, 1), b3 + hstep, voffB); PG8_STAGE(PG8_SA(1, 0), a3, voffA);
            PG8_WAIT_V(8); PG8_WAIT_L(0); PG8_BAR; PG8_MMA(1, 0, At, B0); PG8_MMA(1, 1, At, B1); PG8_BAR; PG8_SCHED;
            } else {
            PG8_LDB(B0, 0, 0); PG8_SCHED; PG8_LDA(At, 0, 0); PG8_STAGE(PG8_SA(1, 1), a1 + hstep, voffA);
            PG8_WAIT_L(8); PG8_BAR; PG8_WAIT_L(0); PG8_MMA(0, 0, At, B0); PG8_BAR; PG8_SCHED;
            PG8_LDB(B1, 0, 1); PG8_STAGE(PG8_SB(0, 0), b2, voffB);
            PG8_BAR; PG8_WAIT_L(0); PG8_MMA(0, 1, At, B1); PG8_BAR;
            PG8_LDA(At, 0, 1); PG8_STAGE(PG8_SA(0, 0), a2, voffA);
            PG8_BAR; PG8_WAIT_L(0); PG8_MMA(1, 0, At, B0); PG8_BAR; PG8_SCHED;
            PG8_STAGE(PG8_SB(0, 1), b2 + hstep, voffB);
            PG8_WAIT_V(6); PG8_BAR; PG8_MMA(1, 1, At, B1); PG8_BAR;
            PG8_LDB(B0, 1, 0); PG8_SCHED; PG8_LDA(At, 1, 0); PG8_STAGE(PG8_SA(0, 1), a2 + hstep, voffA);
            PG8_WAIT_L(8); PG8_BAR; PG8_WAIT_L(0); PG8_MMA(0, 0, At, B0); PG8_BAR; PG8_SCHED;
            PG8_LDB(B1, 1, 1); PG8_STAGE(PG8_SB(1, 0), b3, voffB);
            PG8_BAR; PG8_WAIT_L(0); PG8_MMA(0, 1, At, B1); PG8_BAR;
            PG8_LDA(At, 1, 1); PG8_STAGE(PG8_SA(1, 0), a3, voffA);
            PG8_BAR; PG8_WAIT_L(0); PG8_MMA(1, 0, At, B0); PG8_BAR; PG8_SCHED;
            PG8_STAGE(PG8_SB(1, 1), b3 + hstep, voffB);
            PG8_WAIT_V(6); PG8_BAR; PG8_MMA(1, 1, At, B1); PG8_BAR;
            }
        }
        if constexpr (ALIGN_EPI) { if (wr == 0) PG8_BAR; }
        if constexpr (!Epi::AFTER_DRAIN) { E(acc, cur, wr, wc, fr, fq); S.done(cur); }
        if (!has_next) break;
#pragma unroll
        for (int a = 0; a < 2; ++a)
#pragma unroll
            for (int b = 0; b < 2; ++b)
#pragma unroll
                for (int m = 0; m < 4; ++m)
#pragma unroll
                    for (int n = 0; n < 2; ++n) acc[a][b][m][n] = (f32x4){0.f, 0.f, 0.f, 0.f};
        cur = nxt; cA = nA; cB = nB; ++ui;
        if constexpr (ALIGN_EPI) { if (wr == 1) PG8_BAR; }
    }
    PG8_WAIT_V(0);
    if constexpr (!ALIGN_EPI) { if (wr == 0) PG8_BAR; }
    PG8_BAR;
    if constexpr (Epi::AFTER_DRAIN) { E.fused(acc, cur, wr, wc, fr, fq, lds, wid, lane); S.done(cur); }
#undef PG8_SA
#undef PG8_SB
#undef PG8_STAGE
#undef PG8_LDA
#undef PG8_LDB
#undef PG8_MMA
#undef PG8_WAIT_V
#undef PG8_WAIT_L
#undef PG8_BAR
#undef PG8_SCHED
}
}
#define GAS __attribute__((address_space(1)))
#define LAS __attribute__((address_space(3)))
typedef unsigned short bf16;
typedef unsigned v4u __attribute__((ext_vector_type(4)));
typedef float f32x4 __attribute__((ext_vector_type(4)));
typedef short bf16x8 __attribute__((ext_vector_type(8)));
typedef GAS unsigned gu32;
typedef GAS unsigned long long gu64;
#define RLX_AGENT __ATOMIC_RELAXED, __HIP_MEMORY_SCOPE_AGENT
#define LDS_WAIT() asm volatile("s_waitcnt lgkmcnt(0)" ::: "memory")
#define VM_WAIT() asm volatile("s_waitcnt vmcnt(0)" ::: "memory")
__device__ __forceinline__ unsigned long long rt() { return __builtin_amdgcn_s_memrealtime(); }
__device__ __forceinline__ unsigned f2bf(float f) { unsigned u = __builtin_bit_cast(unsigned, f); return (u + 0x7fffu + ((u >> 16) & 1u)) >> 16; }
__device__ __forceinline__ unsigned pk2(float lo, float hi) { return f2bf(lo) | (f2bf(hi) << 16); }

#define XB_TMO      128
#define XB_XCNT(j)  (256  + 64 * (j))
#define XB_XSUB(j)  (1280 + 64 * (j))
#define XB_XGEN(j)  (2304 + 64 * (j))
#define XB_TOP      3328
#define XB_TOPGEN   3392
#define XCD_BAR_WORDS 3456
#define XB_SPIN_CAP (1u << 18)

__device__ __forceinline__ unsigned xb_ld(unsigned* p)              { return __hip_atomic_load(p, __ATOMIC_RELAXED, __HIP_MEMORY_SCOPE_AGENT); }
__device__ __forceinline__ unsigned xb_add(unsigned* p, unsigned v) { return __hip_atomic_fetch_add(p, v, __ATOMIC_RELAXED, __HIP_MEMORY_SCOPE_AGENT); }
__device__ __forceinline__ unsigned xb_xcc_id() { return (unsigned)__builtin_amdgcn_s_getreg((3 << 11) | 20) & 0xFu; }
#define XB_SPIN(cond, bar) do { unsigned _sp = 0; while (cond) { __builtin_amdgcn_s_sleep(1); \
    if ((++_sp & 255u) == 0u) { if (xb_ld(&(bar)[XB_TMO])) break; if (_sp > XB_SPIN_CAP) { atomicAdd(&(bar)[XB_TMO], 1u); break; } } } } while (0)

struct XcdBarrier {
    unsigned* bar; unsigned x;
    volatile LAS unsigned* st;
};

__device__ __forceinline__ XcdBarrier xcd_barrier_post(unsigned* bar, volatile LAS unsigned* st) {
    XcdBarrier b; b.bar = bar; b.x = xb_xcc_id(); b.st = st;
    if (threadIdx.x == 0) (void)xb_add(&bar[XB_XCNT(b.x)], 1u);
    return b;
}
__device__ __forceinline__ void xcd_barrier_complete(unsigned* bar, unsigned x, unsigned& nloc, unsigned& nx) {
    const unsigned G = gridDim.x * gridDim.y * gridDim.z;
    unsigned sum, cnt, mine, sp = 0u;
    for (;;) {
        sum = 0u; cnt = 0u; mine = 0u;
#pragma unroll
        for (unsigned j = 0; j < 16; ++j) { const unsigned c = xb_ld(&bar[XB_XCNT(j)]); sum += c; cnt += (c > 0u) ? 1u : 0u; mine = (j == x) ? c : mine; }
        if (sum == G) break;
        __builtin_amdgcn_s_sleep(1);
        if ((++sp & 255u) == 0u) { if (xb_ld(&bar[XB_TMO])) break; if (sp > XB_SPIN_CAP) { atomicAdd(&bar[XB_TMO], 1u); break; } }
    }
    nloc = mine > 0u ? mine : 1u; nx = cnt > 0u ? cnt : 1u;
}

__device__ __forceinline__ void xcd_barrier(const XcdBarrier& b) {
    asm volatile("s_waitcnt vmcnt(0)" ::: "memory");
    __syncthreads();
    if (threadIdx.x == 0) {
        unsigned* bar = b.bar;
        __builtin_amdgcn_s_waitcnt(0);
        unsigned nloc = b.st[0], nx = b.st[1];
        if (nloc == 0u) { xcd_barrier_complete(bar, b.x, nloc, nx); b.st[0] = nloc; b.st[1] = nx; }
        const unsigned old = xb_add(&bar[XB_XSUB(b.x)], 1u);
        const unsigned gen = old / nloc;
        if (old + 1u == (gen + 1u) * nloc) {
            __builtin_amdgcn_fence(__ATOMIC_RELEASE, "agent");
            asm volatile("s_waitcnt vmcnt(0)" ::: "memory");
            const unsigned og = xb_add(&bar[XB_TOP], 1u);
            const unsigned tg = og / nx;
            if (og + 1u == (tg + 1u) * nx) xb_add(&bar[XB_TOPGEN], 1u);
            else XB_SPIN(xb_ld(&bar[XB_TOPGEN]) == tg, bar);
            __builtin_amdgcn_fence(__ATOMIC_ACQUIRE, "agent");
            xb_add(&bar[XB_XGEN(b.x)], 1u);
            asm volatile("s_waitcnt vmcnt(0)" ::: "memory");
        } else {
            XB_SPIN(xb_ld(&bar[XB_XGEN(b.x)]) == gen, bar);
            __builtin_amdgcn_fence(__ATOMIC_ACQUIRE, "agent");
            asm volatile("s_waitcnt vmcnt(0)" ::: "memory");
        }
    }
    __syncthreads();
}
constexpr int NWAVES = 8, NTHR = 512;
constexpr int DM = 2048, NB = 4, SEQ = 2048, DEPTH = 4, DB = 32, HD = 128, NLH = 8, NAH = 8, NKV = 2, WIN = 128;
constexpr int DFF = 5632, INW = 5632;
constexpr int MP = NB * SEQ, MS = DB, MV = MP + MS, MPAD = 8448;
constexpr int NMOD = NB + DB;
constexpr int MODW = 6 * DM;
constexpr float EPS = 1e-6f;
constexpr float ATT_SCALE = 0.08838834764831845f;
constexpr int C_QL = 0, C_FL = 1024, C_IL = 2048, C_GL = 3072, C_QA = 4096, C_KA = 5120, C_VA = 5376;
constexpr size_t O_YP = 0, O_YS = O_YP + (size_t)MP * DM, O_KP = O_YS + (size_t)MS * DM, O_VP = O_KP + (size_t)DEPTH * NB * WIN * 256,
                 O_SP = O_VP + (size_t)DEPTH * NB * WIN * 256, O_KS = O_SP + (size_t)DEPTH * NB * NLH * HD * HD, O_VS = O_KS + (size_t)DEPTH * DB * WIN * 256,
                 O_SS = O_VS + (size_t)DEPTH * DB * WIN * 256, O_END = O_SS + (size_t)DEPTH * DB * NLH * HD * HD;
constexpr size_t MiB = 1u << 20;
constexpr size_t WS_CTL = 0, CTL_ZERO_BYTES = 1 * MiB;
constexpr size_t SZ_WIN = (size_t)INW * DM * 2, SZ_WOUT = (size_t)DM * DM * 2, SZ_WGU = (size_t)2 * DFF * DM * 2, SZ_WDN = (size_t)DM * DFF * 2;
constexpr size_t SZ_WL = SZ_WIN + SZ_WOUT + SZ_WGU + SZ_WDN;
constexpr size_t WS_W = 2 * MiB;
constexpr size_t WS_MOD = WS_W + DEPTH * SZ_WL;
constexpr size_t WS_LB = WS_MOD + (size_t)DEPTH * NMOD * MODW * 4;
constexpr size_t WS_X = WS_LB + 64 * 1024;
constexpr size_t WS_H = WS_X + (size_t)MPAD * DM * 4;
constexpr size_t WS_PROJ = WS_H + (size_t)MPAD * DM * 2;
constexpr size_t WS_KN = WS_PROJ + (size_t)MPAD * INW * 4;
constexpr size_t WS_MIX = WS_KN + (size_t)MPAD * 256 * 4;
constexpr size_t WS_FF = WS_MIX + (size_t)MPAD * DM * 2;
constexpr size_t WS_END = WS_FF + (size_t)MPAD * DFF * 2;
constexpr int CW_TMO = 0, CW_BAR = 4096;
constexpr int RING_OFF = 0, RING_BYTES = 131072;
constexpr int LDSCTL_OFF = RING_BYTES, MISC_OFF = LDSCTL_OFF + 320;
constexpr int LDS_BYTES = 147456;

struct Args { const float* in[21]; float* out; unsigned char* ws; int l_lo, l_hi, ph_lo, ph_hi, fused, pad; };

__device__ __forceinline__ float wave_sum(float v) {
#pragma unroll
    for (int o = 1; o < 64; o <<= 1) v += __shfl_xor(v, o);
    return v;
}
__device__ __forceinline__ float siluf(float x) { return x / (1.0f + __expf(-x)); }

__device__ __forceinline__ void p0_transpose_item(const float* W, int K, int N, bf16* WT, int k0, int n0, int dst_row0, LAS float* scr, int lane) {
#pragma unroll 8
    for (int i = 0; i < 32; ++i) { const int kk = 2 * i + (lane >> 5); scr[kk * 33 + (lane & 31)] = W[(size_t)(k0 + kk) * N + n0 + (lane & 31)]; }
    LDS_WAIT(); asm volatile("" ::: "memory");
    const int c = lane & 7;
#pragma unroll
    for (int j = 0; j < 4; ++j) { const int n = (lane >> 3) + 8 * j; const LAS float* s = scr + (8 * c) * 33 + n;
        v4u o; o.x = pk2(s[0 * 33], s[1 * 33]); o.y = pk2(s[2 * 33], s[3 * 33]); o.z = pk2(s[4 * 33], s[5 * 33]); o.w = pk2(s[6 * 33], s[7 * 33]);
        *(GAS v4u*)(WT + (size_t)(dst_row0 + n) * K + k0 + 8 * c) = o; }
    LDS_WAIT(); asm volatile("" ::: "memory");
}

struct Frame {
    LAS unsigned char* lds; volatile LAS unsigned* MISC;
    int tid, lane, wave, bid, G;
};
typedef __attribute__((address_space(4))) const unsigned char* kargp_t;
__device__ __forceinline__ kargp_t karg_base() { kargp_t p = (kargp_t)__builtin_amdgcn_kernarg_segment_ptr(); asm volatile("" : "+s"(p)); return p; }
__device__ __forceinline__ const float* karg_in(int k) { return *(const float* __attribute__((address_space(4))) const*)(karg_base() + 8 * k); }
__device__ __forceinline__ float* karg_out() { return *(float* __attribute__((address_space(4))) const*)(karg_base() + 8 * 21); }
__device__ __forceinline__ unsigned char* karg_ws() { return *(unsigned char* __attribute__((address_space(4))) const*)(karg_base() + 8 * 22); }
enum { I_XP = 0, I_XS, I_CK, I_CV, I_ST, I_CP, I_CS, I_LBND, I_WADA, I_BADA, I_NMIX, I_WIN, I_QN, I_KNRM, I_SINK, I_GN, I_WOUT, I_NFFN, I_WG, I_WU, I_WD };
struct Ptrs {
    const float *x_prompt, *x_sample, *cache_k, *cache_v, *state, *c_prompt, *c_sample, *lower_bounds, *w_ada, *b_ada, *norm_mix, *w_in, *q_norm, *k_norm, *sinks, *g_norm, *w_out, *norm_ffn, *w_gate, *w_up, *w_down;
    float* out; unsigned char* ws; gu32* ctl;
    float *MOD, *LB, *X, *PROJ, *KN; bf16 *H, *MIX, *FF;
};
__device__ __forceinline__ Ptrs load_ptrs() {
    kargp_t kb = karg_base(); Ptrs P;
#define KIN(k) (*(const float* __attribute__((address_space(4))) const*)(kb + 8 * (k)))
    P.x_prompt = KIN(0); P.x_sample = KIN(1); P.cache_k = KIN(2); P.cache_v = KIN(3); P.state = KIN(4); P.c_prompt = KIN(5); P.c_sample = KIN(6); P.lower_bounds = KIN(7);
    P.w_ada = KIN(8); P.b_ada = KIN(9); P.norm_mix = KIN(10); P.w_in = KIN(11); P.q_norm = KIN(12); P.k_norm = KIN(13); P.sinks = KIN(14); P.g_norm = KIN(15);
    P.w_out = KIN(16); P.norm_ffn = KIN(17); P.w_gate = KIN(18); P.w_up = KIN(19); P.w_down = KIN(20);
#undef KIN
    P.out = *(float* __attribute__((address_space(4))) const*)(kb + 8 * 21); P.ws = *(unsigned char* __attribute__((address_space(4))) const*)(kb + 8 * 22);
    P.ctl = (gu32*)(P.ws + WS_CTL);
    P.MOD = (float*)(P.ws + WS_MOD); P.LB = (float*)(P.ws + WS_LB); P.X = (float*)(P.ws + WS_X); P.PROJ = (float*)(P.ws + WS_PROJ); P.KN = (float*)(P.ws + WS_KN);
    P.H = (bf16*)(P.ws + WS_H); P.MIX = (bf16*)(P.ws + WS_MIX); P.FF = (bf16*)(P.ws + WS_FF);
    return P;
}
__device__ __forceinline__ Frame fresh(const Frame& F0) {
    Frame F = F0; int t = F0.tid, b = F0.bid, g = F0.G; asm volatile("" : "+v"(t)); asm volatile("" : "+s"(b), "+s"(g));
    F.tid = t; F.lane = t & 63; F.wave = __builtin_amdgcn_readfirstlane(t >> 6); F.bid = b; F.G = g; return F;
}
__device__ __forceinline__ bf16* wl_in(unsigned char* ws, int l)  { return (bf16*)(ws + WS_W + (size_t)l * SZ_WL); }
__device__ __forceinline__ bf16* wl_out(unsigned char* ws, int l) { return (bf16*)(ws + WS_W + (size_t)l * SZ_WL + SZ_WIN); }
__device__ __forceinline__ bf16* wl_gu(unsigned char* ws, int l)  { return (bf16*)(ws + WS_W + (size_t)l * SZ_WL + SZ_WIN + SZ_WOUT); }
__device__ __forceinline__ bf16* wl_dn(unsigned char* ws, int l)  { return (bf16*)(ws + WS_W + (size_t)l * SZ_WL + SZ_WIN + SZ_WOUT + SZ_WGU); }

__device__ __forceinline__ void p0_prologue(const Frame& F0) {
    Frame F = fresh(F0);
    const Ptrs P = load_ptrs();
    LAS float* scr = (LAS float*)(F.lds + RING_OFF + F.wave * 16384);
    const int gw = F.bid * NWAVES + F.wave, NGW = F.G * NWAVES;
    constexpr int I_IN = 32 * 176, I_OUT = 32 * 64, I_G = 32 * 176, I_DN = 88 * 64, I_L = I_IN + I_OUT + 2 * I_G + I_DN;
    for (int it = gw; it < DEPTH * I_L; it += NGW) {
        const int l = it / I_L; int r = it % I_L;
        if (r < I_IN) { const int kb = r / 176, nb = r % 176; p0_transpose_item(P.w_in + (size_t)l * DM * INW, DM, INW, wl_in(P.ws, l), kb * 64, nb * 32, nb * 32, scr, F.lane); continue; } r -= I_IN;
        if (r < I_OUT) { const int kb = r / 64, nb = r % 64; p0_transpose_item(P.w_out + (size_t)l * DM * DM, DM, DM, wl_out(P.ws, l), kb * 64, nb * 32, nb * 32, scr, F.lane); continue; } r -= I_OUT;
        if (r < I_G) { const int kb = r / 176, nb = r % 176, n0 = nb * 32; p0_transpose_item(P.w_gate + (size_t)l * DM * DFF, DM, DFF, wl_gu(P.ws, l), kb * 64, n0, (n0 >> 7) * 256 + (n0 & 127), scr, F.lane); continue; } r -= I_G;
        if (r < I_G) { const int kb = r / 176, nb = r % 176, n0 = nb * 32; p0_transpose_item(P.w_up + (size_t)l * DM * DFF, DM, DFF, wl_gu(P.ws, l), kb * 64, n0, (n0 >> 7) * 256 + 128 + (n0 & 127), scr, F.lane); continue; } r -= I_G;
        { const int kb = r / 64, nb = r % 64; p0_transpose_item(P.w_down + (size_t)l * DFF * DM, DFF, DM, wl_dn(P.ws, l), kb * 64, nb * 32, nb * 32, scr, F.lane); }
    }
    { const int gt = F.bid * NTHR + F.tid, NGT = F.G * NTHR; const int n4 = MPAD * DM / 4, np4 = MP * DM / 4, nv4 = MV * DM / 4;
      for (int i = gt; i < n4; i += NGT) { f32x4 v = (f32x4){0.f, 0.f, 0.f, 0.f}; if (i < np4) v = ((const f32x4*)P.x_prompt)[i]; else if (i < nv4) v = ((const f32x4*)P.x_sample)[i - np4]; ((f32x4*)P.X)[i] = v; } }
    { const int gt = F.bid * NTHR + F.tid; if (gt < 1024) { float a0 = P.lower_bounds[gt], a1 = P.lower_bounds[1024 + gt], a2 = P.lower_bounds[2048 + gt], a3 = P.lower_bounds[3072 + gt];
        const float mx = fmaxf(fmaxf(a0, a1), fmaxf(a2, a3)); a0 = __expf(a0 - mx); a1 = __expf(a1 - mx); a2 = __expf(a2 - mx); a3 = __expf(a3 - mx); const float inv = 1.f / (a0 + a1 + a2 + a3);
        P.LB[gt] = 0.f; P.LB[1024 + gt] = a1 * inv; P.LB[2048 + gt] = (a1 + a2) * inv; P.LB[3072 + gt] = (a1 + a2 + a3) * inv; } }
    __syncthreads();
    { LAS float* cs = (LAS float*)(F.lds + RING_OFF) + F.wave * (NMOD * 32);
      LAS float* red = (LAS float*)(F.lds + RING_OFF + 40960);
      for (int it = F.bid; it < DEPTH * (MODW / 64); it += F.G) {
          const int l = it / (MODW / 64), e0 = (it % (MODW / 64)) * 64;
          float acc[NMOD];
#pragma unroll
          for (int r = 0; r < NMOD; ++r) acc[r] = 0.f;
          const float* wp = P.w_ada + ((size_t)l * DM + F.wave * 256) * MODW + e0 + F.lane;
          for (int dc = 0; dc < 256; dc += 32) {
#pragma unroll
              for (int i = 0; i < 18; ++i) { const int e = i * 64 + F.lane, r = e >> 5, dd = e & 31; const int d = F.wave * 256 + dc + dd;
                  const float cv = r < NB ? P.c_prompt[r * DM + d] : P.c_sample[(r - NB) * DM + d]; cs[r * 32 + dd] = siluf(cv); }
              LDS_WAIT(); asm volatile("" ::: "memory");
#pragma unroll 2
              for (int d4 = 0; d4 < 32; d4 += 4) {
                  const float w0 = wp[(size_t)(dc + d4 + 0) * MODW], w1 = wp[(size_t)(dc + d4 + 1) * MODW], w2 = wp[(size_t)(dc + d4 + 2) * MODW], w3 = wp[(size_t)(dc + d4 + 3) * MODW];
#pragma unroll
                  for (int r = 0; r < NMOD; ++r) { const f32x4 c4 = *(const LAS f32x4*)(cs + r * 32 + d4); acc[r] += c4.x * w0 + c4.y * w1 + c4.z * w2 + c4.w * w3; }
              }
              LDS_WAIT(); asm volatile("" ::: "memory");
          }
#pragma unroll
          for (int r = 0; r < NMOD; ++r) red[(F.wave * NMOD + r) * 64 + F.lane] = acc[r];
          __syncthreads();
          for (int o = F.tid; o < NMOD * 64; o += NTHR) { const int r = o >> 6, c = o & 63; float s = P.b_ada[l * MODW + e0 + c];
#pragma unroll
              for (int k = 0; k < 8; ++k) s += red[(k * NMOD + r) * 64 + c];
              P.MOD[((size_t)l * NMOD + r) * MODW + e0 + c] = s; }
          __syncthreads();
      }
    }
}

__device__ __forceinline__ void norm_phase(const Frame& F0, int l, int which) {
    Frame F = fresh(F0);
    const Ptrs P = load_ptrs(); const float* gvec = (which ? P.norm_ffn : P.norm_mix) + l * DM; const int sh_off = which ? 3 * DM : 0, sc_off = which ? 4 * DM : DM;
    const int gw = F.bid * NWAVES + F.wave, NGW = F.G * NWAVES;
    for (int row = gw; row < MPAD; row += NGW) {
        GAS unsigned long long* o8 = (GAS unsigned long long*)(P.H + (size_t)row * DM) + F.lane;
        if (row >= MV) {
#pragma unroll
            for (int j = 0; j < 8; ++j) o8[64 * j] = 0ull;
            continue; }
        const GAS f32x4* xr = (const GAS f32x4*)(P.X + (size_t)row * DM) + F.lane;
        f32x4 v[8]; float s = 0.f;
#pragma unroll
        for (int j = 0; j < 8; ++j) { v[j] = xr[64 * j]; s += (v[j].x * v[j].x + v[j].y * v[j].y) + (v[j].z * v[j].z + v[j].w * v[j].w); }
        const float rstd = 1.0f / sqrtf(wave_sum(s) * (1.f / DM) + EPS);
        const float* mod = P.MOD + ((size_t)l * NMOD + pg8::mod_row(row)) * MODW;
        const GAS f32x4* gp = (const GAS f32x4*)gvec + F.lane; const GAS f32x4* shp = (const GAS f32x4*)(mod + sh_off) + F.lane; const GAS f32x4* scp = (const GAS f32x4*)(mod + sc_off) + F.lane;
#pragma unroll
        for (int j = 0; j < 8; ++j) { const f32x4 g = gp[64 * j], sh = shp[64 * j], sc = scp[64 * j]; const f32x4 h = v[j] * rstd * g * (sc + 1.0f) + sh;
            o8[64 * j] = (unsigned long long)pk2(h.x, h.y) | ((unsigned long long)pk2(h.z, h.w) << 32); }
    }
}

__device__ __forceinline__ void prep_phase(const Frame& F0, int l) {
    Frame F = fresh(F0);
    const Ptrs P = load_ptrs();
    const int gw = F.bid * NWAVES + F.wave, NGW = F.G * NWAVES;
    typedef float f32x2v __attribute__((ext_vector_type(2)));
    const f32x2v kn = *(const f32x2v*)(P.k_norm + l * HD + 2 * F.lane);
    for (int it = gw; it < MV * 2; it += NGW) {
        const int row = it >> 1, kvh = it & 1;
        const float* pr = P.PROJ + (size_t)row * INW + kvh * HD + 2 * F.lane;
        const f32x2v k = *(const f32x2v*)(pr + C_KA), v = *(const f32x2v*)(pr + C_VA);
        const float rstd = 1.0f / sqrtf(wave_sum(k.x * k.x + k.y * k.y) * (1.f / HD) + EPS);
        const f32x2v ko = k * rstd * kn;
        *(f32x2v*)(P.KN + (size_t)row * 256 + kvh * HD + 2 * F.lane) = ko;
        if (row < MP) { const int b = row >> 11, t = row & 2047;
            if (t >= SEQ - WIN) { const size_t off = ((((size_t)l * NB + b) * WIN + (t - (SEQ - WIN))) * 2 + kvh) * HD + 2 * F.lane; *(f32x2v*)(P.out + O_KP + off) = ko; *(f32x2v*)(P.out + O_VP + off) = v; } }
        else { const int b = row - MP; const size_t off = ((((size_t)l * DB + b) * WIN + (WIN - 1)) * 2 + kvh) * HD + 2 * F.lane; *(f32x2v*)(P.out + O_KS + off) = ko; *(f32x2v*)(P.out + O_VS + off) = v; }
    }
    { const int gt = F.bid * NTHR + F.tid, NGT = F.G * NTHR; constexpr int per_b = (WIN - 1) * 64;
      for (int i = gt; i < DB * per_b; i += NGT) { const int b = i / per_b, rem = i % per_b, w = rem >> 6, c4 = rem & 63;
          const size_t src = (((size_t)l * DB + b) * WIN + w + 1) * 256 + c4 * 4, dst = (((size_t)l * DB + b) * WIN + w) * 256 + c4 * 4;
          *(f32x4*)(P.out + O_KS + dst) = *(const f32x4*)(P.cache_k + src); *(f32x4*)(P.out + O_VS + dst) = *(const f32x4*)(P.cache_v + src); } }
}

__device__ __forceinline__ void hgrn_unit(Frame& F, const Ptrs& P, int l, int u) {
    int b, h, T, row0; const float* s0; float* sout;
    if (u < 32) { b = u >> 3; h = u & 7; T = SEQ; row0 = b * SEQ; s0 = nullptr; sout = P.out + O_SP + (((size_t)l * NB + b) * NLH + h) * (HD * HD); }
    else { const int us = u - 32; b = us >> 3; h = us & 7; T = 1; row0 = MP + b; s0 = P.state + (((size_t)l * DB + b) * NLH + h) * (HD * HD); sout = P.out + O_SS + (((size_t)l * DB + b) * NLH + h) * (HD * HD); }
    const int v = F.tid >> 2, kq = F.tid & 3;
    float S[32];
#pragma unroll
    for (int j = 0; j < 32; ++j) S[j] = s0 ? s0[(kq * 32 + j) * HD + v] : 0.f;
    LAS float* Fs = (LAS float*)(F.lds + RING_OFF); LAS float* Ks = Fs + 2048; LAS float* Qs = Ks + 2048; LAS float* Vs = Qs + 2048; LAS float* Gs = Vs + 2048; LAS float* Os = Gs + 2048;
    const float gn0 = P.g_norm[l * HD + F.lane], gn1 = P.g_norm[l * HD + 64 + F.lane];
    for (int t0 = 0; t0 < T; t0 += 16) {
        const int nt = (T - t0) < 16 ? (T - t0) : 16;
        for (int e = F.tid; e < nt * HD; e += NTHR) { const int tt = e >> 7, k = e & 127; const float* pr = P.PROJ + (size_t)(row0 + t0 + tt) * INW + h * HD + k;
            const float q = pr[C_QL], vv = pr[C_IL], g = pr[C_GL]; float f = pr[C_FL]; const float lb = P.LB[l * 1024 + h * HD + k];
            f = fmaxf(f, -80.f); const float ex = __expf(-f), sg = 1.0f / (1.0f + ex);
            Fs[e] = lb + (1.0f - lb) * sg; Ks[e] = (1.0f - lb) * (ex * sg); Qs[e] = siluf(q); Vs[e] = vv; Gs[e] = siluf(g); }
        __syncthreads();
        for (int tt = 0; tt < nt; ++tt) {
            const float vt = Vs[tt * HD + v]; float o = 0.f;
#pragma unroll
            for (int j = 0; j < 32; ++j) { const int k = kq * 32 + j; S[j] = Fs[tt * HD + k] * S[j] + Ks[tt * HD + k] * vt; o += S[j] * Qs[tt * HD + k]; }
            o += __shfl_xor(o, 1); o += __shfl_xor(o, 2);
            if (kq == 0) Os[tt * HD + v] = o;
        }
        __syncthreads();
        for (int tt = F.wave; tt < nt; tt += NWAVES) { const float o0 = Os[tt * HD + F.lane], o1 = Os[tt * HD + 64 + F.lane];
            const float rstd = 1.0f / sqrtf(wave_sum(o0 * o0 + o1 * o1) * (1.f / HD) + EPS);
            bf16* mp = P.MIX + (size_t)(row0 + t0 + tt) * DM + h * HD;
            mp[F.lane] = (bf16)f2bf(o0 * rstd * gn0 * Gs[tt * HD + F.lane]); mp[64 + F.lane] = (bf16)f2bf(o1 * rstd * gn1 * Gs[tt * HD + 64 + F.lane]); }
        __syncthreads();
    }
#pragma unroll
    for (int j = 0; j < 32; ++j) sout[(kq * 32 + j) * HD + v] = S[j];
}

__device__ __forceinline__ void attn_item(Frame& F, const Ptrs& P, int l, int item) {
    const int p = item * 128 + (F.tid >> 2), dq = F.tid & 3;
    if (p >= MP * NAH + MS * NAH) return;
    const bool prompt = p < MP * NAH; int b, hq, t, row, nkeys;
    if (prompt) { b = p >> 14; hq = (p >> 11) & 7; t = p & 2047; row = b * SEQ + t; nkeys = (t < WIN ? t : WIN) + 1; }
    else { const int ps = p - MP * NAH; b = ps >> 3; hq = ps & 7; t = 0; row = MP + b; nkeys = WIN + 1; }
    const int kvh = hq >> 2;
    float q[32], acc[32];
    { const float* qp = P.PROJ + (size_t)row * INW + C_QA + hq * HD + dq * 32; float ss = 0.f;
#pragma unroll
      for (int j = 0; j < 32; j += 4) { const f32x4 x = *(const f32x4*)(qp + j); q[j] = x.x; q[j + 1] = x.y; q[j + 2] = x.z; q[j + 3] = x.w; ss += (x.x * x.x + x.y * x.y) + (x.z * x.z + x.w * x.w); }
      ss += __shfl_xor(ss, 1); ss += __shfl_xor(ss, 2);
      const float rstd = 1.0f / sqrtf(ss * (1.f / HD) + EPS) * ATT_SCALE; const float* qn = P.q_norm + l * HD + dq * 32;
#pragma unroll
      for (int j = 0; j < 32; ++j) { q[j] *= rstd * qn[j]; acc[j] = 0.f; } }
    const float slope = exp2f(-(float)(hq + 1));
    float m = P.sinks[l * NAH + hq], den = 1.0f;
    for (int jj = 0; jj < nkeys; ++jj) {
        const float* kp; const float* vp; float dist;
        if (prompt) { const int krow = row - (nkeys - 1) + jj; kp = P.KN + (size_t)krow * 256 + kvh * HD + dq * 32; vp = P.PROJ + (size_t)krow * INW + C_VA + kvh * HD + dq * 32; dist = (float)(nkeys - 1 - jj); }
        else { dist = (float)(WIN - jj);
            if (jj < WIN) { const size_t off = ((((size_t)l * DB + b) * WIN + jj) * 2 + kvh) * HD + dq * 32; kp = P.cache_k + off; vp = P.cache_v + off; }
            else { kp = P.KN + (size_t)row * 256 + kvh * HD + dq * 32; vp = P.PROJ + (size_t)row * INW + C_VA + kvh * HD + dq * 32; } }
        float s = 0.f;
#pragma unroll
        for (int j = 0; j < 32; j += 4) { const f32x4 x = *(const f32x4*)(kp + j); s += (q[j] * x.x + q[j + 1] * x.y) + (q[j + 2] * x.z + q[j + 3] * x.w); }
        s += __shfl_xor(s, 1); s += __shfl_xor(s, 2);
        s -= slope * dist;
        const float mn = fmaxf(m, s), corr = __expf(m - mn), pp = __expf(s - mn);
        den = den * corr + pp; m = mn;
#pragma unroll
        for (int j = 0; j < 32; j += 4) { const f32x4 x = *(const f32x4*)(vp + j); acc[j] = acc[j] * corr + pp * x.x; acc[j + 1] = acc[j + 1] * corr + pp * x.y; acc[j + 2] = acc[j + 2] * corr + pp * x.z; acc[j + 3] = acc[j + 3] * corr + pp * x.w; }
    }
    const float inv = 1.0f / den;
    bf16* mp = P.MIX + (size_t)row * DM + 1024 + hq * HD + dq * 32;
#pragma unroll
    for (int j = 0; j < 32; j += 8) { v4u o; o.x = pk2(acc[j] * inv, acc[j + 1] * inv); o.y = pk2(acc[j + 2] * inv, acc[j + 3] * inv); o.z = pk2(acc[j + 4] * inv, acc[j + 5] * inv); o.w = pk2(acc[j + 6] * inv, acc[j + 7] * inv); *(v4u*)(mp + j) = o; }
}

constexpr int N_HGRN_UNITS = NB * NLH + DB * NLH;
constexpr int N_ATTN_ITEMS = (MP * NAH + MS * NAH + 127) / 128;
__device__ __forceinline__ void mixer_phase(const Frame& F0, int l) {
    Frame F = fresh(F0);
    const Ptrs P = load_ptrs();
    for (int it = F.bid; it < N_HGRN_UNITS + N_ATTN_ITEMS; it += F.G) {
        if (it < N_HGRN_UNITS) hgrn_unit(F, P, l, it); else attn_item(F, P, l, it - N_HGRN_UNITS);
    }
}

__global__ void __launch_bounds__(NTHR, 2) fwd(Args a) {
    extern __shared__ __attribute__((aligned(16))) unsigned char lds[];
    Frame F;
    F.lds = (LAS unsigned char*)lds; F.MISC = (volatile LAS unsigned*)(F.lds + MISC_OFF);
    F.tid = threadIdx.x; F.lane = F.tid & 63; F.wave = __builtin_amdgcn_readfirstlane(F.tid >> 6); F.bid = blockIdx.x; F.G = gridDim.x;
    for (int u = F.tid; u < (LDS_BYTES - LDSCTL_OFF) / 4; u += NTHR) ((LAS unsigned*)(F.lds + LDSCTL_OFF))[u] = 0u;
    __syncthreads();
    XcdBarrier bar; bar.bar = (unsigned*)(a.ws + WS_CTL) + CW_BAR; bar.x = 0; bar.st = nullptr;
    if (a.fused) bar = xcd_barrier_post((unsigned*)(a.ws + WS_CTL) + CW_BAR, F.MISC + 8);
#define IN(k) (a.ph_lo <= (k) && (k) < a.ph_hi)
#define SEAM() do { if (a.fused) xcd_barrier(bar); } while (0)
    if (IN(0)) { p0_prologue(F); SEAM(); }
    for (int l = a.l_lo; l < a.l_hi; ++l) {
        if (IN(1)) { norm_phase(F, l, 0); SEAM(); }
        if (IN(2)) { const Ptrs P = load_ptrs(); pg8::Gemm g{P.H, wl_in(P.ws, l), MPAD, INW, DM}; pg8::StaticOrder S; S.init(MPAD, INW, F.G, F.bid);
            pg8::EpiF32 E{P.PROJ, INW};
            pg8::gemm_phase<pg8::EpiF32, pg8::StaticOrder, true, true>(F.lds + RING_OFF, g, S, E); SEAM(); }
        if (IN(3)) { prep_phase(F, l); SEAM(); }
        if (IN(4)) { mixer_phase(F, l); SEAM(); }
        if (IN(5)) { const Ptrs P = load_ptrs(); const float* modl = P.MOD + (size_t)l * NMOD * MODW; pg8::Gemm g{P.MIX, wl_out(P.ws, l), MPAD, DM, DM}; pg8::StaticOrder S; S.init(MPAD, DM, F.G, F.bid);
            pg8::EpiResid E{P.X, P.X, nullptr, modl + 2 * DM, MODW};
            pg8::gemm_phase<pg8::EpiResid, pg8::StaticOrder, true, true>(F.lds + RING_OFF, g, S, E); SEAM(); }
        if (IN(6)) { norm_phase(F, l, 1); SEAM(); }
        if (IN(7)) { const Ptrs P = load_ptrs(); pg8::Gemm g{P.H, wl_gu(P.ws, l), MPAD, 2 * DFF, DM}; pg8::StaticOrder S; S.init(MPAD, 2 * DFF, F.G, F.bid);
            pg8::EpiSwiglu E{P.FF, DFF};
            pg8::gemm_phase<pg8::EpiSwiglu, pg8::StaticOrder, true, true>(F.lds + RING_OFF, g, S, E); SEAM(); }
        if (IN(8)) { const Ptrs P = load_ptrs(); const float* modl = P.MOD + (size_t)l * NMOD * MODW; pg8::Gemm g{P.FF, wl_dn(P.ws, l), MPAD, DM, DFF}; pg8::StaticOrder S; S.init(MPAD, DM, F.G, F.bid);
            pg8::EpiResid E{P.X, P.X, l == DEPTH - 1 ? P.out : nullptr, modl + 5 * DM, MODW};
            pg8::gemm_phase<pg8::EpiResid, pg8::StaticOrder, true, true>(F.lds + RING_OFF, g, S, E); SEAM(); }
    }
#undef IN
#undef SEAM
}

#ifndef MK_FUSED
#define MK_FUSED 0
#endif
extern "C" void kernel_launch(void* const* d_in, const int* in_sizes, int n_in, void* d_out, int out_size, void* d_ws, size_t ws_size, hipStream_t stream) {
    static int grid = 0;
    if (grid == 0) {
        if (n_in != 21 || (size_t)out_size != O_END || ws_size < WS_END) { fprintf(stderr, "kernel_launch: unexpected shapes: n_in %d out %d (want %zu) ws %zu (want %zu)\n", n_in, out_size, (size_t)O_END, ws_size, (size_t)WS_END); grid = -1; return; }
        int dev = 0, cus = 0, per_cu = 0;
        if (hipGetDevice(&dev) != hipSuccess || hipDeviceGetAttribute(&cus, hipDeviceAttributeMultiprocessorCount, dev) != hipSuccess) { grid = -1; return; }
        if (hipFuncSetAttribute((const void*)fwd, hipFuncAttributeMaxDynamicSharedMemorySize, LDS_BYTES) != hipSuccess) { fprintf(stderr, "kernel_launch: hipFuncSetAttribute failed\n"); grid = -1; return; }
        if (hipOccupancyMaxActiveBlocksPerMultiprocessor(&per_cu, (const void*)fwd, NTHR, LDS_BYTES) != hipSuccess || per_cu < 1) fprintf(stderr, "kernel_launch: occupancy query says %d\n", per_cu);
        (void)hipGetLastError();
        grid = cus;
    }
    if (grid < 0) return;
    if (hipMemsetAsync((char*)d_ws + WS_CTL, 0, CTL_ZERO_BYTES, stream) != hipSuccess) return;
    Args a{};
    for (int i = 0; i < 21; ++i) a.in[i] = (const float*)d_in[i];
    a.out = (float*)d_out; a.ws = (unsigned char*)d_ws;
#if MK_FUSED
    a.l_lo = 0; a.l_hi = DEPTH; a.ph_lo = 0; a.ph_hi = 9; a.fused = 1;
    hipLaunchKernelGGL(fwd, dim3(grid), dim3(NTHR), LDS_BYTES, stream, a);
#else
    a.fused = 0;
    a.l_lo = 0; a.l_hi = 0; a.ph_lo = 0; a.ph_hi = 1;
    hipLaunchKernelGGL(fwd, dim3(grid), dim3(NTHR), LDS_BYTES, stream, a);
    for (int l = 0; l < DEPTH; ++l) for (int ph = 1; ph <= 8; ++ph) { a.l_lo = l; a.l_hi = l + 1; a.ph_lo = ph; a.ph_hi = ph + 1; hipLaunchKernelGGL(fwd, dim3(grid), dim3(NTHR), LDS_BYTES, stream, a); }
#endif
}
```

```cpp
#include <hip/hip_runtime.h>
#include <cstdio>
#include <cstdint>
namespace pg8 {
#define PG8_LAS __attribute__((address_space(3)))
typedef unsigned short bf16_t;
typedef short bf16x8 __attribute__((ext_vector_type(8)));
typedef float f32x4 __attribute__((ext_vector_type(4)));
typedef unsigned u32x4 __attribute__((ext_vector_type(4)));
constexpr int BM = 256, BK = 64, HALF = 128, HTB = HALF * BK * 2  , STAGE_BYTES = 8 * HTB, NXCD = 8, WGM = 4;

__host__ __device__ __forceinline__ int lds_byte(int r, int c) { const int st = (r >> 4) * 2 + (c >> 5), rr = r & 15, cc = c & 31, ob = rr * 64 + cc * 2; return st * 1024 + (ob ^ (((ob >> 9) & 1) << 5)); }
__host__ __device__ __forceinline__ void stage_rc(int b, int& R, int& C) { const int st = b / 1024, sb = b % 1024, swz = sb ^ (((sb >> 9) & 1) << 5); R = (st >> 1) * 16 + swz / 64; C = (st & 1) * 32 + (swz % 64) / 2; }
__host__ __device__ __forceinline__ int perm32(int rho) { const int n = rho >> 4, i = rho & 15; return 8 * (i >> 2) + 4 * n + (i & 3); }

struct Unit { int pm, pn; };
struct Gemm { const bf16_t* A; const bf16_t* Bt; int M, N, K; };

struct StaticOrder {
    int nM, nN, nwg, G, c;
    __host__ __device__ void init(int M, int N, int G_, int c_) { nM = M / BM; nN = N / BM; nwg = nM * nN; G = G_; c = c_; }
    __host__ __device__ bool next(int i, Unit& u) const {
        const long L = (long)i * G + c; if (L >= nwg) return false;
        int wgid = (int)L; { const int q = nwg / NXCD, r = nwg % NXCD, xcd = wgid % NXCD, off = wgid / NXCD; wgid = (xcd < r ? xcd * (q + 1) : r * (q + 1) + (xcd - r) * q) + off; }
        const int nig = WGM * nN, gid = wgid / nig, fm = gid * WGM, gsz = (nM - fm) < WGM ? (nM - fm) : WGM;
        u.pm = fm + ((wgid % nig) % gsz); u.pn = (wgid % nig) / gsz; return true;
    }
    __device__ __forceinline__ void a_ready(const Unit&) const {}
    __device__ __forceinline__ void done(const Unit&) const {}
};

__device__ __forceinline__ unsigned cvt_pk_bf16(float lo, float hi) { unsigned r; asm volatile("v_cvt_pk_bf16_f32 %0, %1, %2" : "=v"(r) : "v"(lo), "v"(hi)); return r; }
typedef float f32x2 __attribute__((ext_vector_type(2)));
__device__ __forceinline__ int mod_row(int r) { return r < 8192 ? (r >> 11) : (r < 8224 ? r - 8192 + 4 : 35); }
struct EpiF32 {
    static constexpr bool PERM = false, AFTER_DRAIN = false;
    float* O; int ldc;
    __device__ __forceinline__ void operator()(const f32x4 (&acc)[2][2][4][2], const Unit& u, int wr, int wc, int fr, int fq) const {
        const int row0 = u.pm * BM + wr * 64 + fr, col0 = u.pn * BM + wc * 32 + 4 * fq;
#pragma unroll
        for (int ai = 0; ai < 2; ++ai)
#pragma unroll
            for (int m = 0; m < 4; ++m) { float* rowp = O + (size_t)(row0 + ai * HALF + m * 16) * ldc + col0;
#pragma unroll
                for (int bj = 0; bj < 2; ++bj)
#pragma unroll
                    for (int n = 0; n < 2; ++n) *(f32x4*)(rowp + bj * HALF + n * 16) = acc[ai][bj][m][n]; }
    }
};
struct EpiResid {
    static constexpr bool PERM = false, AFTER_DRAIN = false;
    const float* Xin; float* Xout; float* Xout2; const float* gate; int ldg;
    __device__ __forceinline__ void operator()(const f32x4 (&acc)[2][2][4][2], const Unit& u, int wr, int wc, int fr, int fq) const {
        const int row0 = u.pm * BM + wr * 64 + fr, col0 = u.pn * BM + wc * 32 + 4 * fq;
        const float* gp = gate + (size_t)(u.pm >> 3) * ldg + col0;
        f32x4 g[2][2];
#pragma unroll
        for (int bj = 0; bj < 2; ++bj)
#pragma unroll
            for (int n = 0; n < 2; ++n) g[bj][n] = *(const f32x4*)(gp + bj * HALF + n * 16);
#pragma unroll
        for (int ai = 0; ai < 2; ++ai)
#pragma unroll
            for (int mp = 0; mp < 2; ++mp) {
                f32x4 xv[2][2][2];
#pragma unroll
                for (int mm = 0; mm < 2; ++mm) { const size_t off = (size_t)(row0 + ai * HALF + (2 * mp + mm) * 16) * 2048 + col0;
#pragma unroll
                    for (int bj = 0; bj < 2; ++bj)
#pragma unroll
                        for (int n = 0; n < 2; ++n) xv[mm][bj][n] = *(const f32x4*)(Xin + off + bj * HALF + n * 16); }
                asm volatile("" ::: "memory");
#pragma unroll
                for (int mm = 0; mm < 2; ++mm) { const int m = 2 * mp + mm; const size_t off = (size_t)(row0 + ai * HALF + m * 16) * 2048 + col0;
#pragma unroll
                    for (int bj = 0; bj < 2; ++bj)
#pragma unroll
                        for (int n = 0; n < 2; ++n) { const f32x4 o = xv[mm][bj][n] + g[bj][n] * acc[ai][bj][m][n]; *(f32x4*)(Xout + off + bj * HALF + n * 16) = o; if (Xout2) *(f32x4*)(Xout2 + off + bj * HALF + n * 16) = o; } }
                asm volatile("" ::: "memory");
            }
    }
};
struct EpiResidB {
    static constexpr bool PERM = true, AFTER_DRAIN = false;
    const float* Xf; bf16_t* Xb; float* Yout; const float* gate; int ldg;
    static __device__ __forceinline__ float lo16(unsigned w) { return __uint_as_float(w << 16); }
    static __device__ __forceinline__ float hi16(unsigned w) { return __uint_as_float(w & 0xffff0000u); }
    __device__ __forceinline__ void operator()(const f32x4 (&acc)[2][2][4][2], const Unit& u, int wr, int wc, int fr, int fq) const {
        const int row0 = u.pm * BM + wr * 64 + fr, col0 = u.pn * BM + wc * 32 + 8 * fq;
        const float* gp = gate + (size_t)(u.pm >> 3) * ldg + col0;
        f32x4 g[2][2];
#pragma unroll
        for (int bj = 0; bj < 2; ++bj)
#pragma unroll
            for (int n = 0; n < 2; ++n) g[bj][n] = *(const f32x4*)(gp + bj * HALF + 4 * n);
        if (!Xf) {
            u32x4 xb[8][2];
#define RB_LOAD(rg) do { const size_t off_ = (size_t)(row0 + ((rg) >> 2) * HALF + ((rg) & 3) * 16) * 2048 + col0; xb[rg][0] = *(const u32x4*)(Xb + off_); xb[rg][1] = *(const u32x4*)(Xb + off_ + HALF); } while (0)
#define RB_DO(rg) do { const int ai_ = (rg) >> 2, m_ = (rg) & 3; const size_t off_ = (size_t)(row0 + ai_ * HALF + m_ * 16) * 2048 + col0; \
                _Pragma("unroll") for (int bj = 0; bj < 2; ++bj) { const u32x4 w = xb[rg][bj]; \
                    const f32x4 x0 = (f32x4){lo16(w.x), hi16(w.x), lo16(w.y), hi16(w.y)}, x1 = (f32x4){lo16(w.z), hi16(w.z), lo16(w.w), hi16(w.w)}; \
                    const f32x4 o0 = x0 + g[bj][0] * acc[ai_][bj][m_][0], o1 = x1 + g[bj][1] * acc[ai_][bj][m_][1]; \
                    if (Yout) { *(f32x4*)(Yout + off_ + bj * HALF) = o0; *(f32x4*)(Yout + off_ + bj * HALF + 4) = o1; } \
                    else { u32x4 v; v.x = cvt_pk_bf16(o0[0], o0[1]); v.y = cvt_pk_bf16(o0[2], o0[3]); v.z = cvt_pk_bf16(o1[0], o1[1]); v.w = cvt_pk_bf16(o1[2], o1[3]); *(u32x4*)(Xb + off_ + bj * HALF) = v; } } } while (0)
            RB_LOAD(0); RB_LOAD(1); RB_LOAD(2); RB_LOAD(3); RB_LOAD(4);
#pragma unroll
            for (int rg = 0; rg < 5; ++rg) asm volatile("" : "+v"(xb[rg][0]), "+v"(xb[rg][1]));
            RB_DO(0); asm volatile("" ::: "memory"); RB_LOAD(5); asm volatile("" ::: "memory");
            RB_DO(1); asm volatile("" ::: "memory"); RB_LOAD(6); asm volatile("" ::: "memory");
            RB_DO(2); asm volatile("" ::: "memory"); RB_LOAD(7); asm volatile("" ::: "memory");
            RB_DO(3); RB_DO(4);
            asm volatile("" : "+v"(xb[5][0]), "+v"(xb[5][1]), "+v"(xb[6][0]), "+v"(xb[6][1]), "+v"(xb[7][0]), "+v"(xb[7][1]));
            RB_DO(5); RB_DO(6); RB_DO(7);
#undef RB_LOAD
#undef RB_DO
            return;
        }
#pragma unroll
        for (int ai = 0; ai < 2; ++ai)
#pragma unroll
            for (int mp = 0; mp < 2; ++mp) {
                f32x4 xv[2][2][2];
#pragma unroll
                for (int mm = 0; mm < 2; ++mm) { const size_t off = (size_t)(row0 + ai * HALF + (2 * mp + mm) * 16) * 2048 + col0;
#pragma unroll
                    for (int bj = 0; bj < 2; ++bj)
#pragma unroll
                        for (int n = 0; n < 2; ++n) xv[mm][bj][n] = *(const f32x4*)(Xf + off + bj * HALF + 4 * n); }
                asm volatile("" ::: "memory");
#pragma unroll
                for (int mm = 0; mm < 2; ++mm) { const int m = 2 * mp + mm; const size_t off = (size_t)(row0 + ai * HALF + m * 16) * 2048 + col0;
#pragma unroll
                    for (int bj = 0; bj < 2; ++bj) { const f32x4 o0 = xv[mm][bj][0] + g[bj][0] * acc[ai][bj][m][0], o1 = xv[mm][bj][1] + g[bj][1] * acc[ai][bj][m][1];
                        if (Yout) { *(f32x4*)(Yout + off + bj * HALF) = o0; *(f32x4*)(Yout + off + bj * HALF + 4) = o1; }
                        else { u32x4 w; w.x = cvt_pk_bf16(o0[0], o0[1]); w.y = cvt_pk_bf16(o0[2], o0[3]); w.z = cvt_pk_bf16(o1[0], o1[1]); w.w = cvt_pk_bf16(o1[2], o1[3]); *(u32x4*)(Xb + off + bj * HALF) = w; } } }
                asm volatile("" ::: "memory");
            }
    }
};
struct EpiSwiglu {
    static constexpr bool PERM = true, AFTER_DRAIN = false;
    bf16_t* O; int ldc;
    __device__ __forceinline__ void operator()(const f32x4 (&acc)[2][2][4][2], const Unit& u, int wr, int wc, int fr, int fq) const {
        const int row0 = u.pm * BM + wr * 64 + fr, col0 = u.pn * HALF + wc * 32 + 8 * fq;
#pragma unroll
        for (int ai = 0; ai < 2; ++ai)
#pragma unroll
            for (int m = 0; m < 4; ++m) { bf16_t* rowp = O + (size_t)(row0 + ai * HALF + m * 16) * ldc + col0;
                float v[8];
#pragma unroll
                for (int n = 0; n < 2; ++n)
#pragma unroll
                    for (int j = 0; j < 4; ++j) { const float g = acc[ai][0][m][n][j], up = acc[ai][1][m][n][j]; v[n * 4 + j] = g * __builtin_amdgcn_rcpf(1.0f + __expf(-g)) * up; }
                u32x4 w; w.x = cvt_pk_bf16(v[0], v[1]); w.y = cvt_pk_bf16(v[2], v[3]); w.z = cvt_pk_bf16(v[4], v[5]); w.w = cvt_pk_bf16(v[6], v[7]);
                *(u32x4*)rowp = w; }
    }
};
struct EpiInProj {
    static constexpr bool PERM = true, AFTER_DRAIN = false;
    bf16_t *QL, *VL, *GL; float* FR; bf16_t *QA, *KA, *VA; float* newv; int novat;
    static __device__ __forceinline__ float silu(float x) { return x * __builtin_amdgcn_rcpf(1.0f + __expf(-x)); }
    static __device__ __forceinline__ u32x4 pack8(const f32x4& a, const f32x4& b) { u32x4 w; w.x = cvt_pk_bf16(a[0], a[1]); w.y = cvt_pk_bf16(a[2], a[3]); w.z = cvt_pk_bf16(b[0], b[1]); w.w = cvt_pk_bf16(b[2], b[3]); return w; }
    __device__ __forceinline__ void operator()(const f32x4 (&acc)[2][2][4][2], const Unit& u, int wr, int wc, int fr, int fq) const {
        const int row0 = u.pm * BM + wr * 64 + fr, d0 = wc * 32 + 8 * fq;
        if (u.pn < 16) {
            const int T = u.pn >> 2;
            if (T == 1) {
#pragma unroll
                for (int bj = 0; bj < 2; ++bj) { const int head = 2 * (u.pn & 3) + bj;
#pragma unroll
                    for (int ai = 0; ai < 2; ++ai)
#pragma unroll
                        for (int m = 0; m < 4; ++m) { const size_t idx = ((size_t)head * 8448 + row0 + ai * HALF + m * 16) * 128 + d0; *(f32x4*)(FR + idx) = acc[ai][bj][m][0]; *(f32x4*)(FR + idx + 4) = acc[ai][bj][m][1]; } }
            } else if (T == 2) {
#pragma unroll
                for (int bj = 0; bj < 2; ++bj) { const int head = 2 * (u.pn & 3) + bj;
#pragma unroll
                    for (int ai = 0; ai < 2; ++ai)
#pragma unroll
                        for (int m = 0; m < 4; ++m) { const size_t idx = ((size_t)head * 8448 + row0 + ai * HALF + m * 16) * 128 + d0; *(u32x4*)(VL + idx) = pack8(acc[ai][bj][m][0], acc[ai][bj][m][1]); } }
            } else {
                bf16_t* dst = T == 0 ? QL : GL;
#pragma unroll
                for (int bj = 0; bj < 2; ++bj) { const int head = 2 * (u.pn & 3) + bj;
#pragma unroll
                    for (int ai = 0; ai < 2; ++ai)
#pragma unroll
                        for (int m = 0; m < 4; ++m) { const size_t idx = ((size_t)head * 8448 + row0 + ai * HALF + m * 16) * 128 + d0; f32x4 v0 = acc[ai][bj][m][0], v1 = acc[ai][bj][m][1];
#pragma unroll
                            for (int j = 0; j < 4; ++j) { v0[j] = silu(v0[j]); v1[j] = silu(v1[j]); }
                            *(u32x4*)(dst + idx) = pack8(v0, v1); } }
            }
        } else {
            bf16_t* dst = QA + (u.pn < 20 ? (size_t)0 : (size_t)8448 * 1024 + (size_t)(u.pn - 20) * ((size_t)8448 * 256)); const int ld = u.pn < 20 ? 1024 : 256, c0 = (u.pn < 20 ? (u.pn - 16) * 256 : 0) + d0;
#pragma unroll
            for (int bj = 0; bj < 2; ++bj)
#pragma unroll
                for (int ai = 0; ai < 2; ++ai)
#pragma unroll
                    for (int m = 0; m < 4; ++m) *(u32x4*)(dst + (size_t)(row0 + ai * HALF + m * 16) * ld + c0 + bj * HALF) = pack8(acc[ai][bj][m][0], acc[ai][bj][m][1]);
        }
        if (u.pn == 21) { const int b = u.pm >> 3;
            if ((u.pm & 7) == 7) {
#pragma unroll
                for (int bj = 0; bj < 2; ++bj)
#pragma unroll
                    for (int m = 0; m < 4; ++m) { float* np = newv + ((size_t)b * 128 + wr * 64 + m * 16 + fr) * 256 + bj * HALF + d0; *(f32x4*)np = acc[1][bj][m][0]; *(f32x4*)(np + 4) = acc[1][bj][m][1]; } }
        }
    }
};
struct EpiProbe {
    static constexpr bool PERM = true, AFTER_DRAIN = false;
    float* sink;
    __device__ __forceinline__ void operator()(const f32x4 (&acc)[2][2][4][2], const Unit& u, int wr, int wc, int fr, int fq) const {
        f32x4 t = (f32x4){0.f, 0.f, 0.f, 0.f};
#pragma unroll
        for (int ai = 0; ai < 2; ++ai)
#pragma unroll
            for (int bj = 0; bj < 2; ++bj)
#pragma unroll
                for (int m = 0; m < 4; ++m)
#pragma unroll
                    for (int n = 0; n < 2; ++n) t += acc[ai][bj][m][n];
        if (t[0] + t[1] + t[2] + t[3] == 123456.789f) sink[u.pm * 22 + u.pn] = t[0];
    }
};
template <class Epi, class Sched, bool ALIGN_EPI = false, bool SP2 = false>
__device__ __forceinline__ void gemm_phase(PG8_LAS unsigned char* lds, const Gemm g, const Sched& S, const Epi& E) {
    int tid_ = threadIdx.x; asm volatile("" : "+v"(tid_));
    const int tid = tid_, wid = __builtin_amdgcn_readfirstlane(tid >> 6), lane = tid & 63, wr = wid >> 2, wc = wid & 3, fr = lane & 15, fq = lane >> 4;
    const int K = g.K, nt = K / BK;
    unsigned voffA[2], voffB[2];
#pragma unroll
    for (int i = 0; i < 2; ++i) { int R, C; stage_rc(tid * 16 + i * 8192, R, C); const int Rb = Epi::PERM ? ((R & ~31) + perm32(R & 31)) : R;
        voffA[i] = (unsigned)(R * K + C) * 2u; voffB[i] = (unsigned)(Rb * K + C) * 2u; }
    const size_t kstep = (size_t)(BK * 2);
    const size_t hstep = (size_t)HALF * K * 2;
    const size_t tstep = 2 * hstep;
    const unsigned ldsw = (unsigned)wid * 1024u;
    const int aoff = lds_byte(wr * 64 + fr, fq * 8), boff = lds_byte(wc * 32 + fr, fq * 8);
#define PG8_SA(b, h) (((b) * 2 + (h)) * HTB)
#define PG8_SB(b, h) ((4 + (b) * 2 + (h)) * HTB)
#define PG8_STAGE(bufoff, gbase, voff) do { _Pragma("unroll") for (int _i = 0; _i < 2; ++_i) \
        __builtin_amdgcn_global_load_lds((const unsigned*)((const char*)(gbase) + (voff)[_i]), (PG8_LAS unsigned*)(lds + (bufoff) + ldsw + _i * 8192), 16, 0, 0); } while (0)
#define PG8_LDA(dst, b, h) do { _Pragma("unroll") for (int m = 0; m < 4; ++m) _Pragma("unroll") for (int k = 0; k < 2; ++k) dst[m][k] = *(const PG8_LAS bf16x8*)(lds + PG8_SA(b, h) + aoff + m * 2048 + k * 1024); } while (0)
#define PG8_LDB(dst, b, h) do { _Pragma("unroll") for (int n = 0; n < 2; ++n) _Pragma("unroll") for (int k = 0; k < 2; ++k) dst[n][k] = *(const PG8_LAS bf16x8*)(lds + PG8_SB(b, h) + boff + n * 2048 + k * 1024); } while (0)
#define PG8_MMA(ai, bj, At, Bt) do { __builtin_amdgcn_s_setprio(1); _Pragma("unroll") for (int m = 0; m < 4; ++m) _Pragma("unroll") for (int n = 0; n < 2; ++n) _Pragma("unroll") for (int k = 0; k < 2; ++k) \
        acc[ai][bj][m][n] = __builtin_amdgcn_mfma_f32_16x16x32_bf16(Bt[n][k], At[m][k], acc[ai][bj][m][n], 0, 0, 0); __builtin_amdgcn_s_setprio(0); } while (0)
#define PG8_WAIT_V(n) asm volatile("s_waitcnt vmcnt(" #n ")" ::: "memory")
#define PG8_WAIT_L(n) asm volatile("s_waitcnt lgkmcnt(" #n ")" ::: "memory")
#define PG8_BAR __builtin_amdgcn_s_barrier()
#define PG8_SCHED __builtin_amdgcn_sched_barrier(0)
    Unit cur, nxt; int ui = 0;
    if (!S.next(0, cur)) return;
    f32x4 acc[2][2][4][2];
#pragma unroll
    for (int a = 0; a < 2; ++a)
#pragma unroll
        for (int b = 0; b < 2; ++b)
#pragma unroll
            for (int m = 0; m < 4; ++m)
#pragma unroll
                for (int n = 0; n < 2; ++n) acc[a][b][m][n] = (f32x4){0.f, 0.f, 0.f, 0.f};
    bf16x8 At[4][2], B0[2][2], B1[2][2];
    const char* cA = (const char*)g.A + (size_t)cur.pm * tstep; const char* cB = (const char*)g.Bt + (size_t)cur.pn * tstep;
    S.a_ready(cur);
    if constexpr (SP2) {
        PG8_STAGE(PG8_SB(0, 0), cB, voffB); PG8_STAGE(PG8_SB(0, 1), cB + hstep, voffB); PG8_STAGE(PG8_SA(0, 0), cA, voffA); PG8_STAGE(PG8_SA(0, 1), cA + hstep, voffA);
        if (wr == 1) PG8_BAR;
        PG8_WAIT_V(2); PG8_BAR;
        PG8_STAGE(PG8_SB(1, 0), cB + kstep, voffB); PG8_STAGE(PG8_SA(1, 0), cA + kstep, voffA); PG8_STAGE(PG8_SB(1, 1), cB + hstep + kstep, voffB);
        PG8_WAIT_V(6); PG8_BAR;
    } else {
        PG8_STAGE(PG8_SB(0, 0), cB, voffB); PG8_STAGE(PG8_SA(0, 0), cA, voffA); PG8_STAGE(PG8_SB(0, 1), cB + hstep, voffB); PG8_STAGE(PG8_SA(0, 1), cA + hstep, voffA);
        if (wr == 1) PG8_BAR;
        PG8_WAIT_V(4); PG8_BAR;
        PG8_STAGE(PG8_SB(1, 0), cB + kstep, voffB); PG8_STAGE(PG8_SA(1, 0), cA + kstep, voffA); PG8_STAGE(PG8_SB(1, 1), cB + hstep + kstep, voffB);
        PG8_WAIT_V(6); PG8_BAR;
    }
    for (;;) {
        const bool has_next = S.next(ui + 1, nxt);
        const char* nA = has_next ? (const char*)g.A + (size_t)nxt.pm * tstep : cA; const char* nB = has_next ? (const char*)g.Bt + (size_t)nxt.pn * tstep : cB;
        for (int t = 0; t < nt; t += 2) {
            const bool last = (t == nt - 2);
            const char* a1 = cA + (size_t)(t + 1) * kstep;
            const char* a2 = last ? nA : cA + (size_t)(t + 2) * kstep; const char* b2 = last ? nB : cB + (size_t)(t + 2) * kstep;
            const char* a3 = a2 + kstep; const char* b3 = b2 + kstep;
            if (last && has_next) S.a_ready(nxt);
            if constexpr (SP2) {
            PG8_LDB(B0, 0, 0); PG8_LDB(B1, 0, 1); PG8_SCHED; PG8_LDA(At, 0, 0); PG8_STAGE(PG8_SA(1, 1), a1 + hstep, voffA);
            PG8_WAIT_V(8); PG8_WAIT_L(0); PG8_BAR; PG8_MMA(0, 0, At, B0); PG8_MMA(0, 1, At, B1); PG8_BAR; PG8_SCHED;
            PG8_LDA(At, 0, 1); PG8_STAGE(PG8_SB(0, 0), b2, voffB); PG8_STAGE(PG8_SB(0, 1), b2 + hstep, voffB); PG8_STAGE(PG8_SA(0, 0), a2, voffA);
            PG8_WAIT_V(8); PG8_WAIT_L(0); PG8_BAR; PG8_MMA(1, 0, At, B0); PG8_MMA(1, 1, At, B1); PG8_BAR; PG8_SCHED;
            PG8_LDB(B0, 1, 0); PG8_LDB(B1, 1, 1); PG8_SCHED; PG8_LDA(At, 1, 0); PG8_STAGE(PG8_SA(0, 1), a2 + hstep, voffA);
            PG8_WAIT_V(8); PG8_WAIT_L(0); PG8_BAR; PG8_MMA(0, 0, At, B0); PG8_MMA(0, 1, At, B1); PG8_BAR; PG8_SCHED;
            PG8_LDA(At, 1, 1); PG8_STAGE(PG8_SB(1, 0), b3, voffB); PG8_STAGE(PG8_SB(1, 1), b3 + hstep, voffB); PG8_STAGE(PG8_SA(1, 0), a3, voffA);
            PG8_WAIT_V(8); PG8_WAIT_L(0); PG8_BAR; PG8_MMA(1, 0, At, B0); PG8_MMA(1, 1, At, B1); PG8_BAR; PG8_SCHED;
            } else {
            PG8_LDB(B0, 0, 0); PG8_SCHED; PG8_LDA(At, 0, 0); PG8_STAGE(PG8_SA(1, 1), a1 + hstep, voffA);
            PG8_WAIT_L(8); PG8_BAR; PG8_WAIT_L(0); PG8_MMA(0, 0, At, B0); PG8_BAR; PG8_SCHED;
            PG8_LDB(B1, 0, 1); PG8_STAGE(PG8_SB(0, 0), b2, voffB);
            PG8_BAR; PG8_WAIT_L(0); PG8_MMA(0, 1, At, B1); PG8_BAR;
            PG8_LDA(At, 0, 1); PG8_STAGE(PG8_SA(0, 0), a2, voffA);
            PG8_BAR; PG8_WAIT_L(0); PG8_MMA(1, 0, At, B0); PG8_BAR; PG8_SCHED;
            PG8_STAGE(PG8_SB(0, 1), b2 + hstep, voffB);
            PG8_WAIT_V(6); PG8_BAR; PG8_MMA(1, 1, At, B1); PG8_BAR;
            PG8_LDB(B0, 1, 0); PG8_SCHED; PG8_LDA(At, 1, 0); PG8_STAGE(PG8_SA(0, 1), a2 + hstep, voffA);
            PG8_WAIT_L(8); PG8_BAR; PG8_WAIT_L(0); PG8_MMA(0, 0, At, B0); PG8_BAR; PG8_SCHED;
            PG8_LDB(B1, 1, 1); PG8_STAGE(PG8_SB(1, 0), b3, voffB);
            PG8_BAR; PG8_WAIT_L(0); PG8_MMA(0, 1, At, B1); PG8_BAR;
            PG8_LDA(At, 1, 1); PG8_STAGE(PG8_SA(1, 0), a3, voffA);
            PG8_BAR; PG8_WAIT_L(0); PG8_MMA(1, 0, At, B0); PG8_BAR; PG8_SCHED;
            PG8_STAGE(PG8_SB(1, 1), b3 + hstep, voffB);
            PG8_WAIT_V(6); PG8_BAR; PG8_MMA(1, 1, At, B1); PG8_BAR;
            }
        }
        if constexpr (ALIGN_EPI) { if (wr == 0) PG8_BAR; }
        if constexpr (!Epi::AFTER_DRAIN) { E(acc, cur, wr, wc, fr, fq); S.done(cur); }
        if (!has_next) break;
#pragma unroll
        for (int a = 0; a < 2; ++a)
#pragma unroll
            for (int b = 0; b < 2; ++b)
#pragma unroll
                for (int m = 0; m < 4; ++m)
#pragma unroll
                    for (int n = 0; n < 2; ++n) acc[a][b][m][n] = (f32x4){0.f, 0.f, 0.f, 0.f};
        cur = nxt; cA = nA; cB = nB; ++ui;
        if constexpr (ALIGN_EPI) { if (wr == 1) PG8_BAR; }
    }
    PG8_WAIT_V(0);
    if constexpr (!ALIGN_EPI) { if (wr == 0) PG8_BAR; }
    PG8_BAR;
    if constexpr (Epi::AFTER_DRAIN) { E.fused(acc, cur, wr, wc, fr, fq, lds, wid, lane); S.done(cur); }
#undef PG8_SA
#undef PG8_SB
#undef PG8_STAGE
#undef PG8_LDA
#undef PG8_LDB
#undef PG8_MMA
#undef PG8_WAIT_V
#undef PG8_WAIT_L
#undef PG8_BAR
#undef PG8_SCHED
}
}
#define GAS __attribute__((address_space(1)))
#define LAS __attribute__((address_space(3)))
typedef unsigned short bf16;
typedef unsigned v4u __attribute__((ext_vector_type(4)));
typedef float f32x4 __attribute__((ext_vector_type(4)));
typedef short bf16x8 __attribute__((ext_vector_type(8)));
typedef GAS unsigned gu32;
typedef GAS unsigned long long gu64;
#define RLX_AGENT __ATOMIC_RELAXED, __HIP_MEMORY_SCOPE_AGENT
#define LDS_WAIT() asm volatile("s_waitcnt lgkmcnt(0)" ::: "memory")
#define VM_WAIT() asm volatile("s_waitcnt vmcnt(0)" ::: "memory")
__device__ __forceinline__ unsigned long long rt() { return __builtin_amdgcn_s_memrealtime(); }
__device__ __forceinline__ unsigned f2bf(float f) { unsigned u = __builtin_bit_cast(unsigned, f); return (u + 0x7fffu + ((u >> 16) & 1u)) >> 16; }
__device__ __forceinline__ unsigned pk2(float lo, float hi) { return f2bf(lo) | (f2bf(hi) << 16); }

#define XB_TMO      128
#define XB_XCNT(j)  (256  + 64 * (j))
#define XB_XSUB(j)  (1280 + 64 * (j))
#define XB_XGEN(j)  (2304 + 64 * (j))
#define XB_TOP      3328
#define XB_TOPGEN   3392
#define XCD_BAR_WORDS 3456
#define XB_SPIN_CAP (1u << 18)

__device__ __forceinline__ unsigned xb_ld(unsigned* p)              { return __hip_atomic_load(p, __ATOMIC_RELAXED, __HIP_MEMORY_SCOPE_AGENT); }
__device__ __forceinline__ unsigned xb_add(unsigned* p, unsigned v) { return __hip_atomic_fetch_add(p, v, __ATOMIC_RELAXED, __HIP_MEMORY_SCOPE_AGENT); }
__device__ __forceinline__ unsigned xb_xcc_id() { return (unsigned)__builtin_amdgcn_s_getreg((3 << 11) | 20) & 0xFu; }
#define XB_SPIN(cond, bar) do { unsigned _sp = 0; while (cond) { __builtin_amdgcn_s_sleep(1); \
    if ((++_sp & 255u) == 0u) { if (xb_ld(&(bar)[XB_TMO])) break; if (_sp > XB_SPIN_CAP) { atomicAdd(&(bar)[XB_TMO], 1u); break; } } } } while (0)

struct XcdBarrier {
    unsigned* bar; unsigned x;
    volatile LAS unsigned* st;
};

__device__ __forceinline__ XcdBarrier xcd_barrier_post(unsigned* bar, volatile LAS unsigned* st) {
    XcdBarrier b; b.bar = bar; b.x = xb_xcc_id(); b.st = st;
    if (threadIdx.x == 0) (void)xb_add(&bar[XB_XCNT(b.x)], 1u);
    return b;
}
__device__ __forceinline__ void xcd_barrier_complete(unsigned* bar, unsigned x, unsigned& nloc, unsigned& nx) {
    const unsigned G = gridDim.x * gridDim.y * gridDim.z;
    unsigned sum, cnt, mine, sp = 0u;
    for (;;) {
        sum = 0u; cnt = 0u; mine = 0u;
#pragma unroll
        for (unsigned j = 0; j < 16; ++j) { const unsigned c = xb_ld(&bar[XB_XCNT(j)]); sum += c; cnt += (c > 0u) ? 1u : 0u; mine = (j == x) ? c : mine; }
        if (sum == G) break;
        __builtin_amdgcn_s_sleep(1);
        if ((++sp & 255u) == 0u) { if (xb_ld(&bar[XB_TMO])) break; if (sp > XB_SPIN_CAP) { atomicAdd(&bar[XB_TMO], 1u); break; } }
    }
    nloc = mine > 0u ? mine : 1u; nx = cnt > 0u ? cnt : 1u;
}

__device__ __forceinline__ void xcd_barrier(const XcdBarrier& b) {
    asm volatile("s_waitcnt vmcnt(0)" ::: "memory");
    __syncthreads();
    if (threadIdx.x == 0) {
        unsigned* bar = b.bar;
        __builtin_amdgcn_s_waitcnt(0);
        unsigned nloc = b.st[0], nx = b.st[1];
        if (nloc == 0u) { xcd_barrier_complete(bar, b.x, nloc, nx); b.st[0] = nloc; b.st[1] = nx; }
        const unsigned old = xb_add(&bar[XB_XSUB(b.x)], 1u);
        const unsigned gen = old / nloc;
        if (old + 1u == (gen + 1u) * nloc) {
            __builtin_amdgcn_fence(__ATOMIC_RELEASE, "agent");
            asm volatile("s_waitcnt vmcnt(0)" ::: "memory");
            const unsigned og = xb_add(&bar[XB_TOP], 1u);
            const unsigned tg = og / nx;
            if (og + 1u == (tg + 1u) * nx) xb_add(&bar[XB_TOPGEN], 1u);
            else XB_SPIN(xb_ld(&bar[XB_TOPGEN]) == tg, bar);
            __builtin_amdgcn_fence(__ATOMIC_ACQUIRE, "agent");
            xb_add(&bar[XB_XGEN(b.x)], 1u);
            asm volatile("s_waitcnt vmcnt(0)" ::: "memory");
        } else {
            XB_SPIN(xb_ld(&bar[XB_XGEN(b.x)]) == gen, bar);
            __builtin_amdgcn_fence(__ATOMIC_ACQUIRE, "agent");
            asm volatile("s_waitcnt vmcnt(0)" ::: "memory");
        }
    }
    __syncthreads();
}
constexpr int NWAVES = 8, NTHR = 512;
constexpr int DM = 2048, NB = 4, SEQ = 2048, DEPTH = 4, DB = 32, HD = 128, NLH = 8, NAH = 8, NKV = 2, WIN = 128;
constexpr int DFF = 5632, INW = 5632;
constexpr int MP = NB * SEQ, MS = DB, MV = MP + MS, MPAD = 8448;
constexpr int NMOD = NB + DB;
constexpr int MODW = 6 * DM;
constexpr float EPS = 1e-6f;
constexpr float ATT_SCALE = 0.08838834764831845f;
constexpr int C_QL = 0, C_FL = 1024, C_IL = 2048, C_GL = 3072, C_QA = 4096, C_KA = 5120, C_VA = 5376;
constexpr size_t O_YP = 0, O_YS = O_YP + (size_t)MP * DM, O_KP = O_YS + (size_t)MS * DM, O_VP = O_KP + (size_t)DEPTH * NB * WIN * 256,
                 O_SP = O_VP + (size_t)DEPTH * NB * WIN * 256, O_KS = O_SP + (size_t)DEPTH * NB * NLH * HD * HD, O_VS = O_KS + (size_t)DEPTH * DB * WIN * 256,
                 O_SS = O_VS + (size_t)DEPTH * DB * WIN * 256, O_END = O_SS + (size_t)DEPTH * DB * NLH * HD * HD;
constexpr size_t MiB = 1u << 20;
constexpr size_t WS_CTL = 0, CTL_ZERO_BYTES = 1 * MiB;
constexpr size_t SZ_WIN = (size_t)INW * DM * 2, SZ_WOUT = (size_t)DM * DM * 2, SZ_WGU = (size_t)2 * DFF * DM * 2, SZ_WDN = (size_t)DM * DFF * 2;
constexpr size_t SZ_WL = SZ_WIN + SZ_WOUT + SZ_WGU + SZ_WDN;
constexpr size_t WS_W = 2 * MiB;
constexpr size_t WS_MOD = WS_W + DEPTH * SZ_WL;
constexpr size_t WS_LB = WS_MOD + (size_t)DEPTH * NMOD * MODW * 4;
constexpr size_t WS_X = WS_LB + 64 * 1024;
constexpr size_t WS_H = WS_X + (size_t)MPAD * DM * 4;
constexpr size_t WS_PROJ = WS_H + (size_t)MPAD * DM * 2;
constexpr size_t WS_KN = WS_PROJ + (size_t)MPAD * INW * 4;
constexpr size_t WS_MIX = WS_KN + (size_t)MPAD * 256 * 4;
constexpr size_t WS_FF = WS_MIX + (size_t)MPAD * DM * 2;
constexpr size_t WS_U = WS_FF + (size_t)MPAD * DFF * 2;
constexpr size_t WS_DG = WS_U + (size_t)256 * HD * HD * 4;
constexpr size_t WS_QL = WS_DG + (size_t)256 * HD * 4;
constexpr size_t WS_VL = WS_QL + (size_t)8 * MPAD * HD * 2;
constexpr size_t WS_GL = WS_VL + (size_t)8 * MPAD * HD * 2;
constexpr size_t WS_FR = WS_GL + (size_t)8 * MPAD * HD * 2;
constexpr size_t WS_QA = WS_FR + (size_t)8 * MPAD * HD * 4;
constexpr size_t WS_KA = WS_QA + (size_t)MPAD * 1024 * 2;
constexpr size_t WS_VA = WS_KA + (size_t)MPAD * 256 * 2;
constexpr size_t WS_END = WS_VA + (size_t)MPAD * 256 * 2;
constexpr int CW_TMO = 0, CW_BAR = 4096;
constexpr int RING_OFF = 0, RING_BYTES = 131072;
constexpr int LDSCTL_OFF = RING_BYTES, MISC_OFF = LDSCTL_OFF + 320;
constexpr int LDS_BYTES = 147456;

struct Args { const float* in[21]; float* out; unsigned char* ws; int l_lo, l_hi, ph_lo, ph_hi, fused, pad; };

__device__ __forceinline__ float dpp_add(float v, float contrib) { return v + contrib; }
#define WS_DPP(v, ctrl, rmask) __builtin_bit_cast(float, __builtin_amdgcn_update_dpp(0, __builtin_bit_cast(int, (v)), (ctrl), (rmask), 0xF, false))
__device__ __forceinline__ float wave_sum(float v) {
    v += WS_DPP(v, 0xB1, 0xF);
    v += WS_DPP(v, 0x4E, 0xF);
    v += WS_DPP(v, 0x141, 0xF);
    v += WS_DPP(v, 0x140, 0xF);
    v += WS_DPP(v, 0x142, 0xA);
    v += WS_DPP(v, 0x143, 0xC);
    return __builtin_bit_cast(float, __builtin_amdgcn_readlane(__builtin_bit_cast(int, v), 63));
}
__device__ __forceinline__ float row16_sum(float v) {
    v += WS_DPP(v, 0xB1, 0xF); v += WS_DPP(v, 0x4E, 0xF); v += WS_DPP(v, 0x141, 0xF); v += WS_DPP(v, 0x140, 0xF);
    return v;
}
__device__ __forceinline__ float siluf(float x) { return x * __builtin_amdgcn_rcpf(1.0f + __expf(-x)); }
typedef float f32x16 __attribute__((ext_vector_type(16)));
typedef __bf16 bf16x2_t __attribute__((ext_vector_type(2)));
typedef float f32x2_t __attribute__((ext_vector_type(2)));
__device__ __forceinline__ unsigned cvt2(float lo, float hi) { f32x2_t v = {lo, hi}; bf16x2_t b = __builtin_convertvector(v, bf16x2_t); return __builtin_bit_cast(unsigned, b); }
__device__ __forceinline__ f32x16 zero16() { f32x16 z;
#pragma unroll
    for (int i = 0; i < 16; ++i) z[i] = 0.f;
    return z; }

struct TrItem { const float* src; bf16* dst; int K, N; };
__device__ __forceinline__ void tr_load(const TrItem& t, float (&wv)[32], int lane) {
    const float* p = t.src + (size_t)(lane >> 5) * t.N + (lane & 31);
#pragma unroll
    for (int i = 0; i < 32; ++i) wv[i] = __builtin_nontemporal_load(p + (size_t)(2 * i) * t.N);
}
__device__ __forceinline__ void tr_process(const TrItem& t, const float (&wv)[32], LAS float* scr, int lane) {
#pragma unroll
    for (int i = 0; i < 32; ++i) scr[(2 * i + (lane >> 5)) * 33 + (lane & 31)] = wv[i];
    LDS_WAIT(); asm volatile("" ::: "memory");
    const int c = lane & 7;
#pragma unroll
    for (int j = 0; j < 4; ++j) { const int n = (lane >> 3) + 8 * j; const LAS float* s = scr + (8 * c) * 33 + n;
        v4u o; o.x = cvt2(s[0 * 33], s[1 * 33]); o.y = cvt2(s[2 * 33], s[3 * 33]); o.z = cvt2(s[4 * 33], s[5 * 33]); o.w = cvt2(s[6 * 33], s[7 * 33]);
        __builtin_nontemporal_store(o, (GAS v4u*)(t.dst + (size_t)n * t.K + 8 * c)); }
    LDS_WAIT(); asm volatile("" ::: "memory");
}

struct Frame {
    LAS unsigned char* lds; volatile LAS unsigned* MISC;
    int tid, lane, wave, bid, G;
};
typedef __attribute__((address_space(4))) const unsigned char* kargp_t;
__device__ __forceinline__ kargp_t karg_base() { kargp_t p = (kargp_t)__builtin_amdgcn_kernarg_segment_ptr(); asm volatile("" : "+s"(p)); return p; }
__device__ __forceinline__ const float* karg_in(int k) { return *(const float* __attribute__((address_space(4))) const*)(karg_base() + 8 * k); }
__device__ __forceinline__ float* karg_out() { return *(float* __attribute__((address_space(4))) const*)(karg_base() + 8 * 21); }
__device__ __forceinline__ unsigned char* karg_ws() { return *(unsigned char* __attribute__((address_space(4))) const*)(karg_base() + 8 * 22); }
enum { I_XP = 0, I_XS, I_CK, I_CV, I_ST, I_CP, I_CS, I_LBND, I_WADA, I_BADA, I_NMIX, I_WIN, I_QN, I_KNRM, I_SINK, I_GN, I_WOUT, I_NFFN, I_WG, I_WU, I_WD };
struct Ptrs {
    const float *x_prompt, *x_sample, *cache_k, *cache_v, *state, *c_prompt, *c_sample, *lower_bounds, *w_ada, *b_ada, *norm_mix, *w_in, *q_norm, *k_norm, *sinks, *g_norm, *w_out, *norm_ffn, *w_gate, *w_up, *w_down;
    float* out; unsigned char* ws; gu32* ctl;
    float *MOD, *LB, *PROJ, *KN; bf16 *XB, *H, *MIX, *FF;
};
__device__ __forceinline__ Ptrs load_ptrs() {
    kargp_t kb = karg_base(); Ptrs P;
#define KIN(k) (*(const float* __attribute__((address_space(4))) const*)(kb + 8 * (k)))
    P.x_prompt = KIN(0); P.x_sample = KIN(1); P.cache_k = KIN(2); P.cache_v = KIN(3); P.state = KIN(4); P.c_prompt = KIN(5); P.c_sample = KIN(6); P.lower_bounds = KIN(7);
    P.w_ada = KIN(8); P.b_ada = KIN(9); P.norm_mix = KIN(10); P.w_in = KIN(11); P.q_norm = KIN(12); P.k_norm = KIN(13); P.sinks = KIN(14); P.g_norm = KIN(15);
    P.w_out = KIN(16); P.norm_ffn = KIN(17); P.w_gate = KIN(18); P.w_up = KIN(19); P.w_down = KIN(20);
#undef KIN
    P.out = *(float* __attribute__((address_space(4))) const*)(kb + 8 * 21); P.ws = *(unsigned char* __attribute__((address_space(4))) const*)(kb + 8 * 22);
    P.ctl = (gu32*)(P.ws + WS_CTL);
    P.MOD = (float*)(P.ws + WS_MOD); P.LB = (float*)(P.ws + WS_LB); P.XB = (bf16*)(P.ws + WS_X); P.PROJ = (float*)(P.ws + WS_PROJ); P.KN = (float*)(P.ws + WS_KN);
    P.H = (bf16*)(P.ws + WS_H); P.MIX = (bf16*)(P.ws + WS_MIX); P.FF = (bf16*)(P.ws + WS_FF);
    return P;
}
__device__ __forceinline__ Frame fresh(const Frame& F0) {
    Frame F = F0; int t = threadIdx.x, b = blockIdx.x, g = gridDim.x; asm volatile("" : "+v"(t)); asm volatile("" : "+s"(b), "+s"(g));
    F.tid = t; F.lane = t & 63; F.wave = __builtin_amdgcn_readfirstlane(t >> 6); F.bid = b; F.G = g; return F;
}
__device__ __forceinline__ bf16* wl_in(unsigned char* ws, int l)  { return (bf16*)(ws + WS_W + (size_t)l * SZ_WL); }
__device__ __forceinline__ bf16* wl_out(unsigned char* ws, int l) { return (bf16*)(ws + WS_W + (size_t)l * SZ_WL + SZ_WIN); }
__device__ __forceinline__ bf16* wl_gu(unsigned char* ws, int l)  { return (bf16*)(ws + WS_W + (size_t)l * SZ_WL + SZ_WIN + SZ_WOUT); }
__device__ __forceinline__ bf16* wl_dn(unsigned char* ws, int l)  { return (bf16*)(ws + WS_W + (size_t)l * SZ_WL + SZ_WIN + SZ_WOUT + SZ_WGU); }

__device__ __forceinline__ void mod_items(const Frame& F, const Ptrs& P, int first, int last, int bid0, int stride, bool stage = true) {
    { LAS float* cpl = (LAS float*)(F.lds + RING_OFF);
      LAS float* red = (LAS float*)(F.lds + RING_OFF + 32768);
      if (stage) { for (int e = F.tid; e < DM * NB; e += NTHR) cpl[e] = siluf(P.c_prompt[(e & 3) * DM + (e >> 2)]);
          __syncthreads(); }
      const int strip = F.wave & 1, kq = F.wave >> 1, hh = F.lane >> 5, cl = F.lane & 31, kb8 = 512 * kq + 8 * hh;
      for (int it = first + F.bid - bid0; it < last; it += stride) {
          const int l = it / (MODW / 64), e0 = (it % (MODW / 64)) * 64;
          const float* wp = P.w_ada + ((size_t)l * DM + kb8) * MODW + e0 + 32 * strip + cl; const float* cp = P.c_sample + (size_t)cl * DM + kb8;
          f32x16 acc = zero16(); float p0 = 0.f, p1 = 0.f, p2 = 0.f, p3 = 0.f;
          float wa[8], wb[8], wc[8], wd[8]; f32x4 ca[2], cb[2], cc[2], cd[2];
#define MOD_LOAD(W_, C_, s) do { _Pragma("unroll") for (int i_ = 0; i_ < 8; ++i_) W_[i_] = __builtin_nontemporal_load(wp + (size_t)((s) * 16 + i_) * MODW); \
                                 C_[0] = *(const f32x4*)(cp + (s) * 16); C_[1] = *(const f32x4*)(cp + (s) * 16 + 4); } while (0)
#define MOD_USE(W_, C_, s) do { v4u aw_, bw_; \
                                 aw_.x = cvt2(siluf(C_[0].x), siluf(C_[0].y)); aw_.y = cvt2(siluf(C_[0].z), siluf(C_[0].w)); aw_.z = cvt2(siluf(C_[1].x), siluf(C_[1].y)); aw_.w = cvt2(siluf(C_[1].z), siluf(C_[1].w)); \
                                 bw_.x = cvt2(W_[0], W_[1]); bw_.y = cvt2(W_[2], W_[3]); bw_.z = cvt2(W_[4], W_[5]); bw_.w = cvt2(W_[6], W_[7]); \
                                 acc = __builtin_amdgcn_mfma_f32_32x32x16_bf16(__builtin_bit_cast(bf16x8, aw_), __builtin_bit_cast(bf16x8, bw_), acc, 0, 0, 0); \
                                 _Pragma("unroll") for (int i_ = 0; i_ < 8; ++i_) { const f32x4 pc_ = *(const LAS f32x4*)(cpl + (kb8 + (s) * 16 + i_) * 4); \
                                     p0 += W_[i_] * pc_.x; p1 += W_[i_] * pc_.y; p2 += W_[i_] * pc_.z; p3 += W_[i_] * pc_.w; } } while (0)
          MOD_LOAD(wa, ca, 0); MOD_LOAD(wb, cb, 1); MOD_LOAD(wc, cc, 2);
#pragma unroll 1
          for (int s = 0; s < 28; s += 4) { MOD_LOAD(wd, cd, s + 3); MOD_USE(wa, ca, s); MOD_LOAD(wa, ca, s + 4); MOD_USE(wb, cb, s + 1); MOD_LOAD(wb, cb, s + 5);
              MOD_USE(wc, cc, s + 2); MOD_LOAD(wc, cc, s + 6); MOD_USE(wd, cd, s + 3); }
          MOD_LOAD(wd, cd, 31); MOD_USE(wa, ca, 28); MOD_USE(wb, cb, 29); MOD_USE(wc, cc, 30); MOD_USE(wd, cd, 31);
#undef MOD_LOAD
#undef MOD_USE
#pragma unroll
          for (int reg = 0; reg < 16; ++reg) red[(F.wave * 20 + reg) * 64 + F.lane] = acc[reg];
          red[(F.wave * 20 + 16) * 64 + F.lane] = p0; red[(F.wave * 20 + 17) * 64 + F.lane] = p1; red[(F.wave * 20 + 18) * 64 + F.lane] = p2; red[(F.wave * 20 + 19) * 64 + F.lane] = p3;
          __syncthreads();
          for (int o = F.tid; o < 2 * NMOD * 32; o += NTHR) { const int st = o / (NMOD * 32), rem = o % (NMOD * 32), row = rem >> 5, n = rem & 31; float sum = 0.f;
              if (row < NB) {
#pragma unroll
                  for (int q = 0; q < 4; ++q) sum += red[((2 * q + st) * 20 + 16 + row) * 64 + n] + red[((2 * q + st) * 20 + 16 + row) * 64 + 32 + n];
              } else { const int r = row - NB, h2 = (r >> 2) & 1, reg = (r & 3) + 4 * (r >> 3);
#pragma unroll
                  for (int q = 0; q < 4; ++q) sum += red[((2 * q + st) * 20 + reg) * 64 + 32 * h2 + n]; }
              const int col = e0 + 32 * st + n; P.MOD[((size_t)l * NMOD + row) * MODW + col] = sum + P.b_ada[l * MODW + col]; }
          __syncthreads();
      }
    }
}

constexpr int I_IN = 32 * 176, I_OUT = 32 * 64, I_G = 32 * 176, I_DN = 88 * 64, I_L = I_IN + I_OUT + 2 * I_G + I_DN;
constexpr int TR_X = 10752, TR_S2 = 8192, TR_S7 = 16384;
constexpr int MOD_P0 = 192;
static_assert(TR_S2 + TR_S7 == I_L && TR_X + TR_S2 >= I_IN + I_OUT + 2 * I_G, "conversion schedule: gate/up(l) complete before layer l's gate/up phase");
__device__ __forceinline__ TrItem tr_decode(const Ptrs& P, int l, int r) {
    TrItem t;
    if (r < I_IN) { const int kb = r / 176, nb = r % 176; t.K = DM; t.N = INW; t.src = P.w_in + (size_t)l * DM * INW + (size_t)(kb * 64) * INW + nb * 32; t.dst = wl_in(P.ws, l) + (size_t)(nb * 32) * DM + kb * 64; return t; } r -= I_IN;
    if (r < I_OUT) { const int kb = r / 64, nb = r % 64; t.K = DM; t.N = DM; t.src = P.w_out + (size_t)l * DM * DM + (size_t)(kb * 64) * DM + nb * 32; t.dst = wl_out(P.ws, l) + (size_t)(nb * 32) * DM + kb * 64; return t; } r -= I_OUT;
    if (r < 2 * I_G) { const int up = r >= I_G ? 1 : 0; r -= up * I_G; const int kb = r / 176, nb = r % 176, n0 = nb * 32; t.K = DM; t.N = DFF; t.src = (up ? P.w_up : P.w_gate) + (size_t)l * DM * DFF + (size_t)(kb * 64) * DFF + n0;
        t.dst = wl_gu(P.ws, l) + (size_t)((n0 >> 7) * 256 + up * 128 + (n0 & 127)) * DM + kb * 64; return t; } r -= 2 * I_G;
    { const int kb = r / 64, nb = r % 64; t.K = DFF; t.N = DM; t.src = P.w_down + (size_t)l * DFF * DM + (size_t)(kb * 64) * DM + nb * 32; t.dst = wl_dn(P.ws, l) + (size_t)(nb * 32) * DFF + kb * 64; return t; }
}
__device__ __forceinline__ void tr_range(const Ptrs& P, LAS float* scr, int lo, int hi, int widx, int nw, int lane) {
    float wa[32], wb[32], wc[32]; TrItem ta, tb, tc;
    int ia = lo + widx, ib = ia + nw, ic = ib + nw;
    if (ia < hi) { ta = tr_decode(P, ia / I_L, ia % I_L); tr_load(ta, wa, lane); }
    if (ib < hi) { tb = tr_decode(P, ib / I_L, ib % I_L); tr_load(tb, wb, lane); }
    while (ia < hi) {
        if (ic < hi) { tc = tr_decode(P, ic / I_L, ic % I_L); tr_load(tc, wc, lane); }
        tr_process(ta, wa, scr, lane); ia = ic + nw;
        if (ib >= hi) break;
        if (ia < hi) { ta = tr_decode(P, ia / I_L, ia % I_L); tr_load(ta, wa, lane); }
        tr_process(tb, wb, scr, lane); ib = ia + nw;
        if (ic >= hi) break;
        if (ib < hi) { tb = tr_decode(P, ib / I_L, ib % I_L); tr_load(tb, wb, lane); }
        tr_process(tc, wc, scr, lane); ic = ib + nw;
    }
}
__device__ __forceinline__ void tr_rider(const Frame& F0, int lo, int hi, int rem, int mfirst = 0, int mlast = 0) {
    Frame F = fresh(F0);
    if (hi > DEPTH * I_L) hi = DEPTH * I_L;
    if (F.bid < rem) return;
    const Ptrs P = load_ptrs();
    if (lo < hi) { tr_range(P, (LAS float*)(F.lds + RING_OFF + F.wave * 16384), lo, hi, (F.bid - rem) * NWAVES + F.wave, (F.G - rem) * NWAVES, F.lane); __syncthreads(); }
    if (mfirst < mlast) mod_items(F, P, mfirst, mlast, rem, F.G - rem);
}

__device__ __forceinline__ void p0_prologue(const Frame& F0) {
    Frame F = fresh(F0);
    const Ptrs P = load_ptrs();
    LAS float* scr = (LAS float*)(F.lds + RING_OFF + F.wave * 16384);
    const int gw = F.bid * NWAVES + F.wave, NGW = F.G * NWAVES;
    tr_range(P, scr, 0, TR_X, gw, NGW, F.lane);
    { const int gt = F.bid * NTHR + F.tid; if (gt < 1024) { float a0 = P.lower_bounds[gt], a1 = P.lower_bounds[1024 + gt], a2 = P.lower_bounds[2048 + gt], a3 = P.lower_bounds[3072 + gt];
        const float mx = fmaxf(fmaxf(a0, a1), fmaxf(a2, a3)); a0 = __expf(a0 - mx); a1 = __expf(a1 - mx); a2 = __expf(a2 - mx); a3 = __expf(a3 - mx); const float inv = 1.f / (a0 + a1 + a2 + a3);
        P.LB[gt] = 0.f; P.LB[1024 + gt] = a1 * inv; P.LB[2048 + gt] = (a1 + a2) * inv; P.LB[3072 + gt] = (a1 + a2 + a3) * inv; } }
    __syncthreads();
    { constexpr int NI = MODW / 64;
      for (int it = F.bid; it < NI + (DEPTH - 1) * MOD_P0; it += F.G) { const int gi = it < NI ? it : NI * (1 + (it - NI) / MOD_P0) + (it - NI) % MOD_P0; mod_items(F, P, gi, gi + 1, F.bid, 1, it == F.bid); } }
}

template <bool FIRST>
__device__ __forceinline__ void norm_sample_row(const Frame& F, const Ptrs& P, const float* gvec, const float* shv, const float* scv, int sr) {
    const int row = MP + sr;
    const GAS f32x4* gp = (const GAS f32x4*)gvec + F.lane; const GAS f32x4* shp = (const GAS f32x4*)shv + F.lane; const GAS f32x4* scp = (const GAS f32x4*)scv + F.lane;
    f32x4 v[8], gr[8], sq[8], Bv[8]; float s = 0.f;
#pragma unroll
    for (int j = 0; j < 8; ++j) { gr[j] = gp[64 * j]; sq[j] = scp[64 * j]; Bv[j] = shp[64 * j]; }
    if (FIRST) { const GAS f32x4* xr = (const GAS f32x4*)(P.x_sample + (size_t)sr * DM) + F.lane;
#pragma unroll
        for (int j = 0; j < 8; ++j) v[j] = xr[64 * j];
#pragma unroll
        for (int j = 0; j < 8; ++j) asm volatile("" : "+v"(v[j])); }
    else { typedef unsigned u32x2_t __attribute__((ext_vector_type(2))); const GAS u32x2_t* xr = (const GAS u32x2_t*)(P.XB + (size_t)row * DM) + F.lane; u32x2_t w[8];
#pragma unroll
        for (int j = 0; j < 8; ++j) w[j] = xr[64 * j];
#pragma unroll
        for (int j = 0; j < 8; ++j) asm volatile("" : "+v"(w[j]));
#pragma unroll
        for (int j = 0; j < 8; ++j) v[j] = (f32x4){__uint_as_float(w[j].x << 16), __uint_as_float(w[j].x & 0xffff0000u), __uint_as_float(w[j].y << 16), __uint_as_float(w[j].y & 0xffff0000u)}; }
#pragma unroll
    for (int j = 0; j < 8; ++j) asm volatile("" : "+v"(gr[j]), "+v"(sq[j]), "+v"(Bv[j]));
#pragma unroll
    for (int j = 0; j < 8; ++j) s += (v[j].x * v[j].x + v[j].y * v[j].y) + (v[j].z * v[j].z + v[j].w * v[j].w);
    const float rstd = __builtin_amdgcn_rsqf(wave_sum(s) * (1.f / DM) + EPS);
    GAS unsigned long long* o8 = (GAS unsigned long long*)(P.H + (size_t)row * DM) + F.lane;
#pragma unroll
    for (int j = 0; j < 8; ++j) { const f32x4 h = v[j] * rstd * (gr[j] * (sq[j] + 1.0f)) + Bv[j]; o8[64 * j] = (unsigned long long)pk2(h.x, h.y) | ((unsigned long long)pk2(h.z, h.w) << 32); }
}
__device__ __forceinline__ void norm_phase(const Frame& F0, int l, int which) {
    Frame F = fresh(F0);
    const Ptrs P = load_ptrs(); const float* gvec = (which ? P.norm_ffn : P.norm_mix) + l * DM; const int sh_off = which ? 3 * DM : 0, sc_off = which ? 4 * DM : DM;
    const bool first = (l == 0 && which == 0);
    for (int bi = F.bid; bi < MP / 32; bi += F.G) {
        const int blk = (4 * (bi & 7) + (bi >> 6)) * 8 + ((bi >> 3) & 7);
        const float* mod = P.MOD + ((size_t)l * NMOD + (blk >> 6)) * MODW;
        const int row0 = 32 * blk + 4 * F.wave;
        if (first) {
            f32x4 A[8], B[8];
            { const GAS f32x4* gp = (const GAS f32x4*)gvec + F.lane; const GAS f32x4* shp = (const GAS f32x4*)(mod + sh_off) + F.lane; const GAS f32x4* scp = (const GAS f32x4*)(mod + sc_off) + F.lane;
              f32x4 gr[8], sr[8];
#pragma unroll
              for (int j = 0; j < 8; ++j) { gr[j] = gp[64 * j]; sr[j] = scp[64 * j]; B[j] = shp[64 * j]; }
#pragma unroll
              for (int j = 0; j < 8; ++j) asm volatile("" : "+v"(gr[j]), "+v"(sr[j]), "+v"(B[j]));
#pragma unroll
              for (int j = 0; j < 8; ++j) A[j] = gr[j] * (sr[j] + 1.0f); }
#pragma unroll
            for (int j = 0; j < 8; ++j) asm volatile("" : "+v"(A[j]));
            f32x4 v[4][8];
#pragma unroll
            for (int r = 0; r < 4; ++r) { const GAS f32x4* xr = (const GAS f32x4*)(P.x_prompt + (size_t)(row0 + r) * DM) + F.lane;
#pragma unroll
                for (int j = 0; j < 8; ++j) v[r][j] = xr[64 * j]; }
#pragma unroll
            for (int r = 0; r < 4; ++r) { float s = 0.f;
#pragma unroll
                for (int j = 0; j < 8; ++j) s += (v[r][j].x * v[r][j].x + v[r][j].y * v[r][j].y) + (v[r][j].z * v[r][j].z + v[r][j].w * v[r][j].w);
                const float rstd = __builtin_amdgcn_rsqf(wave_sum(s) * (1.f / DM) + EPS);
                GAS unsigned long long* o8 = (GAS unsigned long long*)(P.H + (size_t)(row0 + r) * DM) + F.lane;
#pragma unroll
                for (int j = 0; j < 8; ++j) { const f32x4 h = v[r][j] * rstd * A[j] + B[j]; o8[64 * j] = (unsigned long long)pk2(h.x, h.y) | ((unsigned long long)pk2(h.z, h.w) << 32); } }
        } else {
            f32x4 A2[8], B2[8];
            { const GAS f32x4* gp = (const GAS f32x4*)gvec; const GAS f32x4* shp = (const GAS f32x4*)(mod + sh_off); const GAS f32x4* scp = (const GAS f32x4*)(mod + sc_off);
              f32x4 gr[8], sr[8];
#pragma unroll
              for (int jc = 0; jc < 4; ++jc)
#pragma unroll
                  for (int e = 0; e < 2; ++e) { const int q4 = 2 * (F.lane + 64 * jc) + e; gr[2 * jc + e] = gp[q4]; sr[2 * jc + e] = scp[q4]; B2[2 * jc + e] = shp[q4]; }
#pragma unroll
              for (int j = 0; j < 8; ++j) asm volatile("" : "+v"(gr[j]), "+v"(sr[j]), "+v"(B2[j]));
#pragma unroll
              for (int j = 0; j < 8; ++j) A2[j] = gr[j] * (sr[j] + 1.0f); }
#pragma unroll
            for (int j = 0; j < 8; ++j) asm volatile("" : "+v"(A2[j]));
            v4u vp[4][4];
#pragma unroll
            for (int r = 0; r < 4; ++r) { const GAS v4u* xr = (const GAS v4u*)(P.XB + (size_t)(row0 + r) * DM) + F.lane;
#pragma unroll
                for (int jc = 0; jc < 4; ++jc) vp[r][jc] = xr[64 * jc]; }
#pragma unroll
            for (int r = 0; r < 4; ++r) { float s = 0.f;
#pragma unroll
                for (int jc = 0; jc < 4; ++jc) { const v4u w = vp[r][jc];
                    const float x0 = __uint_as_float(w.x << 16), x1 = __uint_as_float(w.x & 0xffff0000u), x2 = __uint_as_float(w.y << 16), x3 = __uint_as_float(w.y & 0xffff0000u);
                    const float x4 = __uint_as_float(w.z << 16), x5 = __uint_as_float(w.z & 0xffff0000u), x6 = __uint_as_float(w.w << 16), x7 = __uint_as_float(w.w & 0xffff0000u);
                    s += ((x0 * x0 + x1 * x1) + (x2 * x2 + x3 * x3)) + ((x4 * x4 + x5 * x5) + (x6 * x6 + x7 * x7)); }
                const float rstd = __builtin_amdgcn_rsqf(wave_sum(s) * (1.f / DM) + EPS);
                GAS v4u* o16 = (GAS v4u*)(P.H + (size_t)(row0 + r) * DM) + F.lane;
#pragma unroll
                for (int jc = 0; jc < 4; ++jc) { const v4u w = vp[r][jc];
                    const f32x4 xa = (f32x4){__uint_as_float(w.x << 16), __uint_as_float(w.x & 0xffff0000u), __uint_as_float(w.y << 16), __uint_as_float(w.y & 0xffff0000u)};
                    const f32x4 xb = (f32x4){__uint_as_float(w.z << 16), __uint_as_float(w.z & 0xffff0000u), __uint_as_float(w.w << 16), __uint_as_float(w.w & 0xffff0000u)};
                    const f32x4 ha = xa * rstd * A2[2 * jc] + B2[2 * jc], hb = xb * rstd * A2[2 * jc + 1] + B2[2 * jc + 1];
                    v4u o; o.x = pk2(ha.x, ha.y); o.y = pk2(ha.z, ha.w); o.z = pk2(hb.x, hb.y); o.w = pk2(hb.z, hb.w); o16[64 * jc] = o; } }
        }
    }
    if (first) { for (int sr = F.bid; sr < MS; sr += F.G) if (F.wave == 0) norm_sample_row<true>(F, P, gvec, P.MOD + ((size_t)l * NMOD + NB + sr) * MODW + sh_off, P.MOD + ((size_t)l * NMOD + NB + sr) * MODW + sc_off, sr); }
    else       { for (int sr = F.bid; sr < MS; sr += F.G) if (F.wave == 0) norm_sample_row<false>(F, P, gvec, P.MOD + ((size_t)l * NMOD + NB + sr) * MODW + sh_off, P.MOD + ((size_t)l * NMOD + NB + sr) * MODW + sc_off, sr); }
}

__device__ __forceinline__ void prep_phase(const Frame& F0, int l) {
    Frame F = fresh(F0);
    const Ptrs P = load_ptrs();
    const int gw = F.bid * NWAVES + F.wave, NGW = F.G * NWAVES;
    typedef float f32x2v __attribute__((ext_vector_type(2)));
    const f32x2v kn = *(const f32x2v*)(P.k_norm + l * HD + 2 * F.lane);
    for (int it = gw; it < MS * 2; it += NGW) {
        const int row = MP + (it >> 1), kvh = it & 1;
        const float* pr = P.PROJ + (size_t)row * INW + kvh * HD + 2 * F.lane;
        const f32x2v k = *(const f32x2v*)(pr + C_KA), v = *(const f32x2v*)(pr + C_VA);
        const float rstd = __builtin_amdgcn_rsqf(wave_sum(k.x * k.x + k.y * k.y) * (1.f / HD) + EPS);
        const f32x2v ko = k * rstd * kn;
        *(f32x2v*)(P.KN + (size_t)row * 256 + kvh * HD + 2 * F.lane) = ko;
        if (row < MP) { const int b = row >> 11, t = row & 2047;
            if (t >= SEQ - WIN) { const size_t off = ((((size_t)l * NB + b) * WIN + (t - (SEQ - WIN))) * 2 + kvh) * HD + 2 * F.lane; *(f32x2v*)(P.out + O_KP + off) = ko; *(f32x2v*)(P.out + O_VP + off) = v; } }
        else { const int b = row - MP; const size_t off = ((((size_t)l * DB + b) * WIN + (WIN - 1)) * 2 + kvh) * HD + 2 * F.lane; *(f32x2v*)(P.out + O_KS + off) = ko; *(f32x2v*)(P.out + O_VS + off) = v; }
    }
}
__device__ __forceinline__ void cache_shift(const Frame& F0, int l) {
    Frame F = fresh(F0);
    const Ptrs P = load_ptrs();
    { const int gt = F.bid * NTHR + F.tid, NGT = F.G * NTHR; constexpr int per_b = (WIN - 1) * 64;
      for (int i = gt; i < DB * per_b; i += NGT) { const int b = i / per_b, rem = i % per_b, w = rem >> 6, c4 = rem & 63;
          const size_t src = (((size_t)l * DB + b) * WIN + w + 1) * 256 + c4 * 4, dst = (((size_t)l * DB + b) * WIN + w) * 256 + c4 * 4;
          __builtin_nontemporal_store(*(const f32x4*)(P.cache_k + src), (f32x4*)(P.out + O_KS + dst)); __builtin_nontemporal_store(*(const f32x4*)(P.cache_v + src), (f32x4*)(P.out + O_VS + dst)); } }
}

__device__ __forceinline__ void hgrn_unit(const Frame& F, const Ptrs& P, int l, int u) {
    const int us = u - 32, b = us >> 3, h = us & 7, row = MP + b;
    const float* s0 = P.state + (((size_t)l * DB + b) * NLH + h) * (HD * HD); float* sout = P.out + O_SS + (((size_t)l * DB + b) * NLH + h) * (HD * HD);
    const int v4 = F.tid & 31, kg = F.tid >> 5;
    LAS float* Fs = (LAS float*)(F.lds + RING_OFF); LAS float* Ks = Fs + 128; LAS float* Qs = Ks + 128; LAS float* Vs = Qs + 128; LAS float* Gs = Vs + 128; LAS float* Os = Gs + 128; LAS float* Rd = Os + 128;
    f32x4 S[8];
#pragma unroll
    for (int j = 0; j < 8; ++j) S[j] = __builtin_nontemporal_load((const f32x4*)(s0 + (size_t)(kg * 8 + j) * HD + 4 * v4));
    const float gn0 = P.g_norm[l * HD + F.lane], gn1 = P.g_norm[l * HD + 64 + F.lane];
    if (F.tid < HD) { const int k = F.tid; const float* pr = P.PROJ + (size_t)row * INW + h * HD + k;
        const float q = pr[C_QL], vv = pr[C_IL], g = pr[C_GL], lb = P.LB[l * 1024 + h * HD + k]; const float f = fmaxf(pr[C_FL], -80.f);
        const float ex = __expf(-f), sg = __builtin_amdgcn_rcpf(1.0f + ex);
        Fs[k] = lb + (1.0f - lb) * sg; Ks[k] = (1.0f - lb) * (ex * sg); Qs[k] = siluf(q); Vs[k] = vv; Gs[k] = siluf(g); }
    __syncthreads();
    { const f32x4 vt = *(const LAS f32x4*)(Vs + 4 * v4); f32x4 o = (f32x4){0.f, 0.f, 0.f, 0.f};
#pragma unroll
      for (int j = 0; j < 8; ++j) { const int k = kg * 8 + j; S[j] = S[j] * Fs[k] + vt * Ks[k]; o += S[j] * Qs[k]; }
#pragma unroll
      for (int c = 0; c < 4; ++c) o[c] += __shfl_xor(o[c], 32);
      if (F.lane < 32) *(LAS f32x4*)(Rd + F.wave * HD + 4 * v4) = o; }
#pragma unroll
    for (int j = 0; j < 8; ++j) __builtin_nontemporal_store(S[j], (f32x4*)(sout + (size_t)(kg * 8 + j) * HD + 4 * v4));
    __syncthreads();
    if (F.wave == 0) { float o0 = 0.f, o1 = 0.f;
#pragma unroll
        for (int w = 0; w < 8; ++w) { o0 += Rd[w * HD + F.lane]; o1 += Rd[w * HD + 64 + F.lane]; }
        const float rstd = __builtin_amdgcn_rsqf(wave_sum(o0 * o0 + o1 * o1) * (1.f / HD) + EPS);
        bf16* mp = P.MIX + (size_t)row * DM + h * HD;
        mp[F.lane] = (bf16)f2bf(o0 * rstd * gn0 * Gs[F.lane]); mp[64 + F.lane] = (bf16)f2bf(o1 * rstd * gn1 * Gs[64 + F.lane]); }
    __syncthreads();
}

__device__ __forceinline__ void attn_item(Frame& F, const Ptrs& P, int l, int item) {
    const int p = item * 128 + (F.tid >> 2), dq = F.tid & 3;
    if (p >= MP * NAH + MS * NAH) return;
    const bool prompt = p < MP * NAH; int b, hq, t, row, nkeys;
    if (prompt) { b = p >> 14; hq = (p >> 11) & 7; t = p & 2047; row = b * SEQ + t; nkeys = (t < WIN ? t : WIN) + 1; }
    else { const int ps = p - MP * NAH; b = ps >> 3; hq = ps & 7; t = 0; row = MP + b; nkeys = WIN + 1; }
    const int kvh = hq >> 2;
    float q[32], acc[32];
    { const float* qp = P.PROJ + (size_t)row * INW + C_QA + hq * HD + dq * 32; float ss = 0.f;
#pragma unroll
      for (int j = 0; j < 32; j += 4) { const f32x4 x = *(const f32x4*)(qp + j); q[j] = x.x; q[j + 1] = x.y; q[j + 2] = x.z; q[j + 3] = x.w; ss += (x.x * x.x + x.y * x.y) + (x.z * x.z + x.w * x.w); }
      ss += __shfl_xor(ss, 1); ss += __shfl_xor(ss, 2);
      const float rstd = __builtin_amdgcn_rsqf(ss * (1.f / HD) + EPS) * ATT_SCALE; const float* qn = P.q_norm + l * HD + dq * 32;
#pragma unroll
      for (int j = 0; j < 32; ++j) { q[j] *= rstd * qn[j]; acc[j] = 0.f; } }
    const float slope = exp2f(-(float)(hq + 1));
    float m = P.sinks[l * NAH + hq], den = 1.0f;
    for (int jj = 0; jj < nkeys; ++jj) {
        const float* kp; const float* vp; float dist;
        if (prompt) { const int krow = row - (nkeys - 1) + jj; kp = P.KN + (size_t)krow * 256 + kvh * HD + dq * 32; vp = P.PROJ + (size_t)krow * INW + C_VA + kvh * HD + dq * 32; dist = (float)(nkeys - 1 - jj); }
        else { dist = (float)(WIN - jj);
            if (jj < WIN) { const size_t off = ((((size_t)l * DB + b) * WIN + jj) * 2 + kvh) * HD + dq * 32; kp = P.cache_k + off; vp = P.cache_v + off; }
            else { kp = P.KN + (size_t)row * 256 + kvh * HD + dq * 32; vp = P.PROJ + (size_t)row * INW + C_VA + kvh * HD + dq * 32; } }
        float s = 0.f;
#pragma unroll
        for (int j = 0; j < 32; j += 4) { const f32x4 x = *(const f32x4*)(kp + j); s += (q[j] * x.x + q[j + 1] * x.y) + (q[j + 2] * x.z + q[j + 3] * x.w); }
        s += __shfl_xor(s, 1); s += __shfl_xor(s, 2);
        s -= slope * dist;
        const float mn = fmaxf(m, s), corr = __expf(m - mn), pp = __expf(s - mn);
        den = den * corr + pp; m = mn;
#pragma unroll
        for (int j = 0; j < 32; j += 4) { const f32x4 x = *(const f32x4*)(vp + j); acc[j] = acc[j] * corr + pp * x.x; acc[j + 1] = acc[j + 1] * corr + pp * x.y; acc[j + 2] = acc[j + 2] * corr + pp * x.z; acc[j + 3] = acc[j + 3] * corr + pp * x.w; }
    }
    const float inv = 1.0f / den;
    bf16* mp = P.MIX + (size_t)row * DM + 1024 + hq * HD + dq * 32;
#pragma unroll
    for (int j = 0; j < 32; j += 8) { v4u o; o.x = pk2(acc[j] * inv, acc[j + 1] * inv); o.y = pk2(acc[j + 2] * inv, acc[j + 3] * inv); o.z = pk2(acc[j + 4] * inv, acc[j + 5] * inv); o.w = pk2(acc[j + 6] * inv, acc[j + 7] * inv); *(v4u*)(mp + j) = o; }
}

__device__ __forceinline__ bf16 cvt1(float x) { return (bf16)(cvt2(x, 0.f) & 0xffffu); }
__device__ __forceinline__ int crow(int reg, int h) { return (reg & 3) + 8 * (reg >> 2) + 4 * h; }
template <int NK>
__device__ __forceinline__ void mma_tile(f32x16& acc, const LAS bf16* X, int sx, const LAS bf16* Y, int sy, int lane) {
    const int r = lane & 31, h = lane >> 5;
    const LAS bf16* xp = X + r * sx + 8 * h; const LAS bf16* yp = Y + r * sy + 8 * h;
    bf16x8 a[NK], b[NK];
#pragma unroll
    for (int ks = 0; ks < NK; ++ks) { a[ks] = *(const LAS bf16x8*)(xp + ks * 16); b[ks] = *(const LAS bf16x8*)(yp + ks * 16); }
    asm volatile("" ::: "memory");
#pragma unroll
    for (int ks = 0; ks < NK; ++ks) acc = __builtin_amdgcn_mfma_f32_32x32x16_bf16(a[ks], b[ks], acc, 0, 0, 0);
}
__device__ __forceinline__ void mma_tile_n(f32x16& acc, const LAS bf16* X, int sx, const LAS bf16* Y, int sy, int nk, int lane) {
    const int r = lane & 31, h = lane >> 5;
    const LAS bf16* xp = X + r * sx + 8 * h; const LAS bf16* yp = Y + r * sy + 8 * h;
    for (int ks = 0; ks < nk; ++ks) { const bf16x8 a = *(const LAS bf16x8*)(xp + ks * 16), b = *(const LAS bf16x8*)(yp + ks * 16);
        acc = __builtin_amdgcn_mfma_f32_32x32x16_bf16(a, b, acc, 0, 0, 0); }
}

constexpr int HG_QT = 0, HG_KT = 17408, HG_KTT = 34816, HG_VT = 53248, HG_AM = 71680, HG_ST = 80896, HG_TOT = 115712, HG_VEC = 119808, HG_OB = HG_KT;
constexpr int SQ = 136, SK = 72, SO = 132;
template <bool FULL, int SKIP = 0>
__device__ __forceinline__ void hgrn_seg(const Frame& F, const Ptrs& P, int l, int unit) {
    const int b = unit >> 6, h = (unit >> 3) & 7, seg = unit & 7, row0 = b * SEQ + seg * 256;
    const int tid = F.tid, lane = F.lane, wave = F.wave, kch = tid & 127, tg = tid >> 7, hh = lane >> 5, cl = lane & 31;
    LAS unsigned char* L = F.lds + RING_OFF;
    LAS bf16* QT = (LAS bf16*)(L + HG_QT); LAS bf16* KT = (LAS bf16*)(L + HG_KT); LAS bf16* KTt = (LAS bf16*)(L + HG_KTT); LAS bf16* Vt = (LAS bf16*)(L + HG_VT);
    LAS bf16* Am = (LAS bf16*)(L + HG_AM); LAS bf16* St = (LAS bf16*)(L + HG_ST); LAS float* tot = (LAS float*)(L + HG_TOT);
    LAS float* er = (LAS float*)(L + HG_VEC); LAS float* e63 = er + 128; LAS float* e63r = er + 256; LAS float* Ob = (LAS float*)(L + HG_OB);
    float* U = (float*)(P.ws + WS_U); float* Dg = (float*)(P.ws + WS_DG);
    const int kb0 = (2 * wave) >> 2, vb0 = (2 * wave) & 3, kb1 = (2 * wave + 1) >> 2, vb1 = (2 * wave + 1) & 3;
    f32x16 S0 = zero16(), S1 = zero16();
    if (FULL && !(SKIP & 1)) {
        LAS float* Wl = (LAS float*)(L + HG_ST);
        const v4u* Ub = (const v4u*)U + ((size_t)(unit - seg) * 8 + wave) * 256 + lane;
        v4u uu[7][4];
#pragma unroll
        for (int j = 0; j < 7; ++j) { uu[j][0] = uu[j][1] = uu[j][2] = uu[j][3] = (v4u){0u, 0u, 0u, 0u};
            if (j < seg) { const v4u* uj = Ub + (size_t)j * 2048; uu[j][0] = uj[0]; uu[j][1] = uj[64]; uu[j][2] = uj[128]; uu[j][3] = uj[192]; } }
        if (tg == 0) { float dgv[7];
#pragma unroll
            for (int j = 0; j < 7; ++j) { dgv[j] = 1.f; if (j < seg) dgv[j] = Dg[(size_t)(unit - seg + j) * HD + kch]; }
#pragma unroll
            for (int j = 0; j < 7; ++j) asm volatile("" : "+v"(dgv[j]));
            float w = 1.f;
#pragma unroll
            for (int j = 6; j >= 0; --j) if (j < seg) { Wl[j * HD + kch] = w; w *= dgv[j]; } }
        __syncthreads();
#pragma unroll
        for (int j = 0; j < 7; ++j) asm volatile("" : "+v"(uu[j][0]), "+v"(uu[j][1]), "+v"(uu[j][2]), "+v"(uu[j][3]));
#pragma unroll
        for (int j = 0; j < 7; ++j) if (j < seg) { const LAS float* wj = Wl + j * HD;
#pragma unroll
            for (int g = 0; g < 4; ++g) { const f32x4 d0 = *(const LAS f32x4*)(wj + 32 * kb0 + 8 * g + 4 * hh), d1 = *(const LAS f32x4*)(wj + 32 * kb1 + 8 * g + 4 * hh);
                const unsigned a0 = (g & 1) ? uu[j][g >> 1].z : uu[j][g >> 1].x, a1 = (g & 1) ? uu[j][g >> 1].w : uu[j][g >> 1].y, b0 = (g & 1) ? uu[j][2 + (g >> 1)].z : uu[j][2 + (g >> 1)].x, b1 = (g & 1) ? uu[j][2 + (g >> 1)].w : uu[j][2 + (g >> 1)].y;
                S0[4 * g] += d0.x * __uint_as_float(a0 << 16); S0[4 * g + 1] += d0.y * __uint_as_float(a0 & 0xffff0000u); S0[4 * g + 2] += d0.z * __uint_as_float(a1 << 16); S0[4 * g + 3] += d0.w * __uint_as_float(a1 & 0xffff0000u);
                S1[4 * g] += d1.x * __uint_as_float(b0 << 16); S1[4 * g + 1] += d1.y * __uint_as_float(b0 & 0xffff0000u); S1[4 * g + 2] += d1.z * __uint_as_float(b1 << 16); S1[4 * g + 3] += d1.w * __uint_as_float(b1 & 0xffff0000u); } }
        __syncthreads();
    }
    typedef float f32x2v __attribute__((ext_vector_type(2)));
    const f32x2v lb2 = *(const f32x2v*)(P.LB + l * 1024 + h * HD + 2 * lane);
    const f32x2v gn2 = *(const f32x2v*)(P.g_norm + l * HD + 2 * lane);
    float Bseg0 = 0.f, Bseg1 = 0.f;
    const size_t hb = ((size_t)h * MPAD + row0 + 8 * wave) * HD + 2 * lane;
    const float* fbase = (const float*)(P.ws + WS_FR) + hb; const bf16* qbase = (const bf16*)(P.ws + WS_QL) + hb; const bf16* vbase = (const bf16*)(P.ws + WS_VL) + hb;
    const bf16* gbase = (const bf16*)(P.ws + WS_GL) + ((size_t)h * MPAD + row0) * HD + 2 * lane;
    f32x2v fv[8]; unsigned qv[8], vv[8];
#pragma unroll
    for (int i = 0; i < 8; ++i) { fv[i] = *(const f32x2v*)(fbase + i * HD); vv[i] = *(const unsigned*)(vbase + i * HD); if (FULL) qv[i] = *(const unsigned*)(qbase + i * HD); }
    for (int c = 0; c < 4; ++c) {
        unsigned gq[8];
        if (FULL) {
#pragma unroll
            for (int tt = 0; tt < 8; ++tt) gq[tt] = *(const unsigned*)(gbase + (size_t)(64 * c + 8 * wave + tt) * HD); }
        float pre0[8], pre1[8], kk0[8], kk1[8]; float run0 = 0.f, run1 = 0.f;
        if (SKIP & 16) {
#pragma unroll
            for (int i = 0; i < 8; ++i) { pre0[i] = pre1[i] = -0.1f * i; kk0[i] = kk1[i] = 0.5f; } run0 = run1 = -0.7f; } else
#pragma unroll
        for (int i = 0; i < 8; ++i) {
            { const float fr = fmaxf(fv[i].x, -80.f); const float ex = __expf(-fr), sg = __builtin_amdgcn_rcpf(1.0f + ex); run0 += __log2f(lb2.x + (1.0f - lb2.x) * sg); pre0[i] = run0; kk0[i] = (1.0f - lb2.x) * (ex * sg); }
            { const float fr = fmaxf(fv[i].y, -80.f); const float ex = __expf(-fr), sg = __builtin_amdgcn_rcpf(1.0f + ex); run1 += __log2f(lb2.y + (1.0f - lb2.y) * sg); pre1[i] = run1; kk1[i] = (1.0f - lb2.y) * (ex * sg); } }
        *(LAS f32x2v*)(tot + wave * 128 + 2 * lane) = (f32x2v){run0, run1};
        __syncthreads();
        float off0 = 0.f, off1 = 0.f, r0 = 0.f, r1 = 0.f, b630 = 0.f, b631 = 0.f;
#pragma unroll
        for (int g = 0; g < 8; ++g) { const f32x2v tv = *(const LAS f32x2v*)(tot + g * 128 + 2 * lane); if (g < wave) { off0 += tv.x; off1 += tv.y; } if (g < 4) { r0 += tv.x; r1 += tv.y; } b630 += tv.x; b631 += tv.y; }
        unsigned kpk0[4], kpk1[4], vpk0[4], vpk1[4];
        if (SKIP & 16) {
#pragma unroll
            for (int i = 0; i < 4; ++i) { kpk0[i] = kpk1[i] = 0x3f003f00u; vpk0[i] = vv[2 * i]; vpk1[i] = vv[2 * i + 1]; } } else
#pragma unroll
        for (int i = 0; i < 8; i += 2) {
            const float bt00 = off0 + pre0[i], bt01 = off1 + pre1[i], bt10 = off0 + pre0[i + 1], bt11 = off1 + pre1[i + 1];
            const float k00 = kk0[i] * __builtin_amdgcn_exp2f(fminf(r0 - bt00, 115.f)), k01 = kk1[i] * __builtin_amdgcn_exp2f(fminf(r1 - bt01, 115.f)), k10 = kk0[i + 1] * __builtin_amdgcn_exp2f(fminf(r0 - bt10, 115.f)), k11 = kk1[i + 1] * __builtin_amdgcn_exp2f(fminf(r1 - bt11, 115.f));
            kpk0[i >> 1] = cvt2(k00, k10); kpk1[i >> 1] = cvt2(k01, k11);
            vpk0[i >> 1] = (vv[i] & 0xffffu) | (vv[i + 1] << 16); vpk1[i >> 1] = (vv[i] >> 16) | (vv[i + 1] & 0xffff0000u);
            if (FULL) {
                const float q00 = __uint_as_float(qv[i] << 16) * __builtin_amdgcn_exp2f(fminf(bt00 - r0, 115.f)), q01 = __uint_as_float(qv[i] & 0xffff0000u) * __builtin_amdgcn_exp2f(fminf(bt01 - r1, 115.f));
                const float q10 = __uint_as_float(qv[i + 1] << 16) * __builtin_amdgcn_exp2f(fminf(bt10 - r0, 115.f)), q11 = __uint_as_float(qv[i + 1] & 0xffff0000u) * __builtin_amdgcn_exp2f(fminf(bt11 - r1, 115.f));
                *(LAS unsigned*)(QT + (8 * wave + i) * SQ + 2 * lane) = cvt2(q00, q01); *(LAS unsigned*)(QT + (8 * wave + i + 1) * SQ + 2 * lane) = cvt2(q10, q11);
                *(LAS unsigned*)(KT + (8 * wave + i) * SQ + 2 * lane) = cvt2(k00, k01); *(LAS unsigned*)(KT + (8 * wave + i + 1) * SQ + 2 * lane) = cvt2(k10, k11); }
        }
        { v4u w; w.x = kpk0[0]; w.y = kpk0[1]; w.z = kpk0[2]; w.w = kpk0[3]; *(LAS v4u*)(KTt + (2 * lane) * SK + 8 * wave) = w;
          w.x = kpk1[0]; w.y = kpk1[1]; w.z = kpk1[2]; w.w = kpk1[3]; *(LAS v4u*)(KTt + (2 * lane + 1) * SK + 8 * wave) = w;
          w.x = vpk0[0]; w.y = vpk0[1]; w.z = vpk0[2]; w.w = vpk0[3]; *(LAS v4u*)(Vt + (2 * lane) * SK + 8 * wave) = w;
          w.x = vpk1[0]; w.y = vpk1[1]; w.z = vpk1[2]; w.w = vpk1[3]; *(LAS v4u*)(Vt + (2 * lane + 1) * SK + 8 * wave) = w; }
        if (wave == 0) { *(LAS f32x2v*)(er + 2 * lane) = (f32x2v){__builtin_amdgcn_exp2f(r0), __builtin_amdgcn_exp2f(r1)}; *(LAS f32x2v*)(e63 + 2 * lane) = (f32x2v){__builtin_amdgcn_exp2f(b630), __builtin_amdgcn_exp2f(b631)}; *(LAS f32x2v*)(e63r + 2 * lane) = (f32x2v){__builtin_amdgcn_exp2f(b630 - r0), __builtin_amdgcn_exp2f(b631 - r1)}; }
        Bseg0 += b630; Bseg1 += b631;
        if (c < 3) {
#pragma unroll
            for (int i = 0; i < 8; ++i) { fv[i] = *(const f32x2v*)(fbase + (64 * (c + 1) + i) * HD); vv[i] = *(const unsigned*)(vbase + (64 * (c + 1) + i) * HD); if (FULL) qv[i] = *(const unsigned*)(qbase + (64 * (c + 1) + i) * HD); } }
        __syncthreads();
        if (!(SKIP & 8)) {
        if (FULL) {
            typedef unsigned u32x2_t __attribute__((ext_vector_type(2)));
            f32x4 ev0[4], ev1[4];
#pragma unroll
            for (int j = 0; j < 4; ++j) { ev0[j] = *(const LAS f32x4*)(er + 32 * kb0 + 8 * j + 4 * hh); ev1[j] = *(const LAS f32x4*)(er + 32 * kb1 + 8 * j + 4 * hh); }
#pragma unroll
            for (int j = 0; j < 4; ++j) {
                { u32x2_t w; w.x = cvt2(S0[4 * j] * ev0[j].x, S0[4 * j + 1] * ev0[j].y); w.y = cvt2(S0[4 * j + 2] * ev0[j].z, S0[4 * j + 3] * ev0[j].w); *(LAS u32x2_t*)(St + (32 * vb0 + cl) * SQ + 32 * kb0 + 8 * j + 4 * hh) = w; }
                { u32x2_t w; w.x = cvt2(S1[4 * j] * ev1[j].x, S1[4 * j + 1] * ev1[j].y); w.y = cvt2(S1[4 * j + 2] * ev1[j].z, S1[4 * j + 3] * ev1[j].w); *(LAS u32x2_t*)(St + (32 * vb1 + cl) * SQ + 32 * kb1 + 8 * j + 4 * hh) = w; }
            }
            if (wave < 3) { const int tb = wave > 0 ? 1 : 0, sb = wave > 1 ? 1 : 0; f32x16 a = zero16();
                mma_tile<8>(a, QT + 32 * tb * SQ, SQ, KT + 32 * sb * SQ, SQ, lane);
#pragma unroll
                for (int reg = 0; reg < 16; ++reg) { const int t = 32 * tb + crow(reg, hh), s = 32 * sb + cl; Am[t * SK + s] = cvt1(s <= t ? a[reg] : 0.f); } }
        }
        { f32x16 p0 = zero16(), p1 = zero16();
          mma_tile<4>(p0, KTt + 32 * kb0 * SK, SK, Vt + 32 * vb0 * SK, SK, lane); mma_tile<4>(p1, KTt + 32 * kb1 * SK, SK, Vt + 32 * vb1 * SK, SK, lane);
#pragma unroll
          for (int j = 0; j < 4; ++j) {
              { const f32x4 a = *(const LAS f32x4*)(e63 + 32 * kb0 + 8 * j + 4 * hh), bq = *(const LAS f32x4*)(e63r + 32 * kb0 + 8 * j + 4 * hh);
                S0[4 * j] = a.x * S0[4 * j] + bq.x * p0[4 * j]; S0[4 * j + 1] = a.y * S0[4 * j + 1] + bq.y * p0[4 * j + 1]; S0[4 * j + 2] = a.z * S0[4 * j + 2] + bq.z * p0[4 * j + 2]; S0[4 * j + 3] = a.w * S0[4 * j + 3] + bq.w * p0[4 * j + 3]; }
              { const f32x4 a = *(const LAS f32x4*)(e63 + 32 * kb1 + 8 * j + 4 * hh), bq = *(const LAS f32x4*)(e63r + 32 * kb1 + 8 * j + 4 * hh);
                S1[4 * j] = a.x * S1[4 * j] + bq.x * p1[4 * j]; S1[4 * j + 1] = a.y * S1[4 * j + 1] + bq.y * p1[4 * j + 1]; S1[4 * j + 2] = a.z * S1[4 * j + 2] + bq.z * p1[4 * j + 2]; S1[4 * j + 3] = a.w * S1[4 * j + 3] + bq.w * p1[4 * j + 3]; }
          } }
        }
        __syncthreads();
        if (FULL) {
            if (!(SKIP & 4)) { const int tb = wave >> 2, vb = wave & 3; f32x16 o = zero16();
              if (tb == 0) mma_tile<2>(o, Am, SK, Vt + 32 * vb * SK, SK, lane); else mma_tile<4>(o, Am + 32 * SK, SK, Vt + 32 * vb * SK, SK, lane);
              mma_tile<8>(o, QT + 32 * tb * SQ, SQ, St + 32 * vb * SQ, SQ, lane);
#pragma unroll
              for (int reg = 0; reg < 16; ++reg) Ob[(32 * tb + crow(reg, hh)) * SO + 32 * vb + cl] = o[reg]; }
            __syncthreads();
            if (!(SKIP & 2))
#pragma unroll
            for (int tt = 0; tt < 8; ++tt) { const int t = 8 * wave + tt; const f32x2v o = *(const LAS f32x2v*)(Ob + t * SO + 2 * lane);
                const float rstd = __builtin_amdgcn_rsqf(wave_sum(o.x * o.x + o.y * o.y) * (1.f / HD) + EPS);
                *(unsigned*)(P.MIX + (size_t)(row0 + 64 * c + t) * DM + h * HD + 2 * lane) = cvt2(o.x * rstd * gn2.x * __uint_as_float(gq[tt] << 16), o.y * rstd * gn2.y * __uint_as_float(gq[tt] & 0xffff0000u)); }
        }
    }
    if (!FULL) {
        v4u* Uu = (v4u*)U + ((size_t)unit * 8 + wave) * 256 + lane;
#pragma unroll
        for (int q = 0; q < 2; ++q) { v4u w0, w1;
            w0.x = cvt2(S0[8 * q], S0[8 * q + 1]); w0.y = cvt2(S0[8 * q + 2], S0[8 * q + 3]); w0.z = cvt2(S0[8 * q + 4], S0[8 * q + 5]); w0.w = cvt2(S0[8 * q + 6], S0[8 * q + 7]);
            w1.x = cvt2(S1[8 * q], S1[8 * q + 1]); w1.y = cvt2(S1[8 * q + 2], S1[8 * q + 3]); w1.z = cvt2(S1[8 * q + 4], S1[8 * q + 5]); w1.w = cvt2(S1[8 * q + 6], S1[8 * q + 7]);
            Uu[64 * q] = w0; Uu[128 + 64 * q] = w1; }
        if (wave == 0) *(f32x2v*)(Dg + (size_t)unit * HD + 2 * lane) = (f32x2v){__builtin_amdgcn_exp2f(Bseg0), __builtin_amdgcn_exp2f(Bseg1)};
    } else if (seg == 7) {
        float* so0 = P.out + O_SP + (((size_t)l * NB + b) * NLH + h) * (HD * HD) + (32 * kb0 + 4 * hh) * HD + 32 * vb0 + cl;
        float* so1 = P.out + O_SP + (((size_t)l * NB + b) * NLH + h) * (HD * HD) + (32 * kb1 + 4 * hh) * HD + 32 * vb1 + cl;
#pragma unroll
        for (int g = 0; g < 4; ++g) {
            __builtin_nontemporal_store(S0[4 * g], so0); __builtin_nontemporal_store(S0[4 * g + 1], so0 + HD); __builtin_nontemporal_store(S0[4 * g + 2], so0 + 2 * HD); __builtin_nontemporal_store(S0[4 * g + 3], so0 + 3 * HD);
            __builtin_nontemporal_store(S1[4 * g], so1); __builtin_nontemporal_store(S1[4 * g + 1], so1 + HD); __builtin_nontemporal_store(S1[4 * g + 2], so1 + 2 * HD); __builtin_nontemporal_store(S1[4 * g + 3], so1 + 3 * HD);
            so0 += 8 * HD; so1 += 8 * HD; asm volatile("" : "+v"(so0), "+v"(so1) :: "memory"); }
    }
    __syncthreads();
}

constexpr int AT_KB = 0, AT_VR = 52224, SVR = 160;
__device__ __forceinline__ void attn_unit(const Frame& F, const Ptrs& P, int l, int unit) {
    const int b = unit >> 6, qblk = (unit >> 1) & 31, kvh = unit & 1;
    const int tid = F.tid, lane = F.lane, wave = F.wave, hh = lane >> 5, cl = lane & 31;
    const int q0 = 64 * qblk, nprev = q0 < WIN ? q0 : WIN, nk = nprev + 64, k0 = q0 - nprev, rowb = b * SEQ;
    LAS unsigned char* L = F.lds + RING_OFF;
    LAS bf16* Kb = (LAS bf16*)(L + AT_KB); LAS bf16* Vr = (LAS bf16*)(L + AT_VR);
    const bf16* QA = (const bf16*)(P.ws + WS_QA); const bf16* KA = (const bf16*)(P.ws + WS_KA); const bf16* VA = (const bf16*)(P.ws + WS_VA);
    const int sub = wave >> 2, hq = kvh * 4 + (wave & 3);
    typedef unsigned u32x2_t __attribute__((ext_vector_type(2)));
    bf16x8 qf[8];
    { const bf16* qp = QA + (size_t)(rowb + q0 + 32 * sub + cl) * 1024 + hq * HD + 8 * hh;
#pragma unroll
      for (int ks = 0; ks < 8; ++ks) qf[ks] = *(const bf16x8*)(qp + 16 * ks); }
    bf16x8 kx[6]; v4u vx[6];
#pragma unroll
    for (int i = 0; i < 6; ++i) { const int idx = tid + NTHR * i; int key = idx >> 4; key = key < nk ? key : nk - 1; const int d8 = (idx & 15) * 8;
        kx[i] = *(const bf16x8*)(KA + (size_t)(rowb + k0 + key) * 256 + kvh * HD + d8); }
#pragma unroll
    for (int i = 0; i < 6; ++i) { const int idx = tid + NTHR * i; int key = idx >> 4; key = key < nk ? key : nk - 1; const int d8 = (idx & 15) * 8;
        vx[i] = *(const v4u*)(VA + (size_t)(rowb + k0 + key) * 256 + kvh * HD + d8); }
    const f32x4 kn0 = *(const f32x4*)(P.k_norm + l * HD + (tid & 15) * 8), kn1 = *(const f32x4*)(P.k_norm + l * HD + (tid & 15) * 8 + 4);
#pragma unroll
    for (int i = 0; i < 6; ++i) { const int idx = tid + NTHR * i, key = idx >> 4, d8 = (idx & 15) * 8;
        float xf[8], ss = 0.f;
#pragma unroll
        for (int j = 0; j < 8; ++j) { xf[j] = __uint_as_float((unsigned)(unsigned short)kx[i][j] << 16); ss += xf[j] * xf[j]; }
        ss = row16_sum(ss);
        const float rs = __builtin_amdgcn_rsqf(ss * (1.f / HD) + EPS);
        xf[0] *= rs * kn0.x; xf[1] *= rs * kn0.y; xf[2] *= rs * kn0.z; xf[3] *= rs * kn0.w; xf[4] *= rs * kn1.x; xf[5] *= rs * kn1.y; xf[6] *= rs * kn1.z; xf[7] *= rs * kn1.w;
        if (key < nk) { v4u w; w.x = cvt2(xf[0], xf[1]); w.y = cvt2(xf[2], xf[3]); w.z = cvt2(xf[4], xf[5]); w.w = cvt2(xf[6], xf[7]); *(LAS v4u*)(Kb + key * SQ + d8) = w;
            if (qblk >= 30 && key >= nprev) { float* op = P.out + O_KP + ((((size_t)l * NB + b) * WIN + (q0 + key - nprev - (SEQ - WIN))) * 2 + kvh) * HD + d8;
                *(f32x4*)op = (f32x4){xf[0], xf[1], xf[2], xf[3]}; *(f32x4*)(op + 4) = (f32x4){xf[4], xf[5], xf[6], xf[7]}; } } }
#pragma unroll
    for (int i = 0; i < 6; ++i) { const int idx = tid + NTHR * i, key = idx >> 4, d8 = (idx & 15) * 8; if (key < nk) *(LAS v4u*)(Vr + key * SVR + d8) = vx[i]; }
    { float ss = 0.f;
#pragma unroll
      for (int ks = 0; ks < 8; ++ks)
#pragma unroll
          for (int j = 0; j < 8; ++j) { const float x = __uint_as_float((unsigned)(unsigned short)qf[ks][j] << 16); ss += x * x; }
      ss += __shfl_xor(ss, 32);
      const float rs = __builtin_amdgcn_rsqf(ss * (1.f / HD) + EPS) * (ATT_SCALE * 1.4426950408889634f); const float* qn = P.q_norm + l * HD + 8 * hh;
#pragma unroll
      for (int ks = 0; ks < 8; ++ks) { const f32x4 n0 = *(const f32x4*)(qn + 16 * ks), n1 = *(const f32x4*)(qn + 16 * ks + 4); float x[8];
#pragma unroll
          for (int j = 0; j < 8; ++j) x[j] = __uint_as_float((unsigned)(unsigned short)qf[ks][j] << 16) * rs;
          v4u w; w.x = cvt2(x[0] * n0.x, x[1] * n0.y); w.y = cvt2(x[2] * n0.z, x[3] * n0.w); w.z = cvt2(x[4] * n1.x, x[5] * n1.y); w.w = cvt2(x[6] * n1.z, x[7] * n1.w);
          qf[ks] = __builtin_bit_cast(bf16x8, w); } }
    __syncthreads();
    const int kb_hi = (nprev + 32 * sub) >> 5;
    const float LOG2E = 1.4426950408889634f;
    const float slope = exp2f(-(float)(hq + 1)) * LOG2E, sink = P.sinks[l * NAH + hq] * LOG2E;
    f32x16 sc[5]; float m = -1e30f;
#pragma unroll
    for (int j = 0; j < 5; ++j) { const int kb = kb_hi - 4 + j; sc[j] = zero16();
        if (kb >= 0) { const LAS bf16* kp = Kb + (32 * kb + cl) * SQ + 8 * hh; bf16x8 kf[8];
#pragma unroll
            for (int ks = 0; ks < 8; ++ks) kf[ks] = *(const LAS bf16x8*)(kp + 16 * ks);
            asm volatile("" ::: "memory");
#pragma unroll
            for (int ks = 0; ks < 8; ++ks) sc[j] = __builtin_amdgcn_mfma_f32_32x32x16_bf16(kf[ks], qf[ks], sc[j], 0, 0, 0); }
        const float base = slope * (float)(32 * (4 - j) + cl - 4 * hh);
#pragma unroll
        for (int reg = 0; reg < 16; ++reg) { const int kr0 = (reg & 3) + 8 * (reg >> 2), krow = kr0 + 4 * hh;
            float sv = sc[j][reg] - (base - slope * (float)kr0);
            if (j == 0) sv = krow >= cl ? sv : -1e30f;
            if (j == 4) sv = krow <= cl ? sv : -1e30f;
            if (kb < 0) sv = -1e30f;
            sc[j][reg] = sv; m = fmaxf(m, sv); } }
    m = fmaxf(m, __shfl_xor(m, 32)); m = fmaxf(m, sink);
    float sum = 0.f;
#pragma unroll
    for (int j = 0; j < 5; ++j)
#pragma unroll
        for (int reg = 0; reg < 16; ++reg) { const float p = __builtin_amdgcn_exp2f(sc[j][reg] - m); sc[j][reg] = p; sum += p; }
    sum += __shfl_xor(sum, 32);
    const float inv = __builtin_amdgcn_rcpf(sum + __builtin_amdgcn_exp2f(sink - m));
    bf16x8 pf[5][2];
#pragma unroll
    for (int j = 0; j < 5; ++j)
#pragma unroll
        for (int s2 = 0; s2 < 2; ++s2) { v4u w; w.x = cvt2(sc[j][8 * s2] * inv, sc[j][8 * s2 + 1] * inv); w.y = cvt2(sc[j][8 * s2 + 2] * inv, sc[j][8 * s2 + 3] * inv);
            w.z = cvt2(sc[j][8 * s2 + 4] * inv, sc[j][8 * s2 + 5] * inv); w.w = cvt2(sc[j][8 * s2 + 6] * inv, sc[j][8 * s2 + 7] * inv); pf[j][s2] = __builtin_bit_cast(bf16x8, w); }
    typedef short v4i16_t __attribute__((ext_vector_type(4)));
    const int trq = (lane & 15) >> 2, trp = lane & 3, trb = (lane >> 4) & 1;
#pragma unroll 1
    for (int db = 0; db < 4; ++db) { f32x16 z = zero16();
#pragma unroll
        for (int j = 0; j < 5; ++j) { const int kb = kb_hi - 4 + j;
            if (kb >= 0) { const LAS bf16* vp = Vr + (32 * kb + 4 * hh + trq) * SVR + 32 * db + 16 * trb + 4 * trp;
#pragma unroll
                for (int s2 = 0; s2 < 2; ++s2) { const v4i16_t lo = __builtin_amdgcn_ds_read_tr16_b64_v4i16((LAS v4i16_t*)(vp + 16 * s2 * SVR)), hi = __builtin_amdgcn_ds_read_tr16_b64_v4i16((LAS v4i16_t*)(vp + (16 * s2 + 8) * SVR));
                    const bf16x8 vfr = __builtin_shufflevector(lo, hi, 0, 1, 2, 3, 4, 5, 6, 7);
                    z = __builtin_amdgcn_mfma_f32_32x32x16_bf16(pf[j][s2], vfr, z, 0, 0, 0); } } }
        bf16* mp = P.MIX + (size_t)(rowb + q0 + 32 * sub) * DM + 1024 + hq * HD + 32 * db + cl;
#pragma unroll
        for (int reg = 0; reg < 16; ++reg) mp[(size_t)crow(reg, hh) * DM] = cvt1(z[reg]); }
    __syncthreads();
}

template <int MODE>
__device__ __forceinline__ void skinny_phase(const Frame& F0, int l) {
    Frame F = fresh(F0); const Ptrs P = load_ptrs();
    constexpr int K = MODE == 3 ? DFF : DM, NT = (MODE == 0 || MODE == 2) ? INW / 32 : DM / 32, KW = K / 8, NKS = KW / 16;
    const bf16* A = (MODE == 1 ? P.MIX : MODE == 3 ? P.FF : P.H) + (size_t)MP * K;
    const bf16* Bt = MODE == 0 ? wl_in(P.ws, l) : MODE == 1 ? wl_out(P.ws, l) : MODE == 2 ? wl_gu(P.ws, l) : wl_dn(P.ws, l);
    LAS float* red = (LAS float*)(F.lds + RING_OFF);
    const int cl = F.lane & 31, hh = F.lane >> 5;
    for (int it = F.G - 1 - F.bid; it < NT; it += F.G) {
        const int n0 = it * 32, brow0 = MODE == 2 ? ((n0 >> 7) * 256 + (n0 & 127)) : n0;
        const bf16* ap = A + (size_t)cl * K + F.wave * KW + 8 * hh;
        const bf16* bp = Bt + (size_t)(brow0 + cl) * K + F.wave * KW + 8 * hh;
        f32x16 acc0 = zero16(), acc1 = zero16();
        float pg[2] = {0.f, 0.f}, px[2] = {0.f, 0.f};
        if (MODE == 1 || MODE == 3) {
#pragma unroll
            for (int oo = 0; oo < 2; ++oo) { const int o = F.tid + NTHR * oo, reg = o >> 6, ln = o & 63, row = crow(reg, ln >> 5), col = n0 + (ln & 31);
                pg[oo] = P.MOD[((size_t)l * NMOD + NB + row) * MODW + (MODE == 1 ? 2 * DM : 5 * DM) + col];
                px[oo] = (MODE == 1 && l == 0) ? P.x_sample[(size_t)row * DM + col] : __uint_as_float((unsigned)P.XB[(size_t)(MP + row) * DM + col] << 16); } }
        constexpr int KB = (NKS % 11 == 0) ? 11 : 8;
        static_assert(NKS % KB == 0, "skinny: k-step batches");
#pragma unroll 1
        for (int k0 = 0; k0 < NKS; k0 += KB) { bf16x8 av[KB], bv0[KB], bv1[KB];
#pragma unroll
            for (int i = 0; i < KB; ++i) { av[i] = *(const bf16x8*)(ap + (k0 + i) * 16); bv0[i] = *(const bf16x8*)(bp + (k0 + i) * 16); if (MODE == 2) bv1[i] = *(const bf16x8*)(bp + (size_t)128 * K + (k0 + i) * 16); }
#pragma unroll
            for (int i = 0; i < KB; ++i) { asm volatile("" : "+v"(av[i]), "+v"(bv0[i])); if (MODE == 2) asm volatile("" : "+v"(bv1[i])); }
#pragma unroll
            for (int i = 0; i < KB; ++i) { acc0 = __builtin_amdgcn_mfma_f32_32x32x16_bf16(av[i], bv0[i], acc0, 0, 0, 0); if (MODE == 2) acc1 = __builtin_amdgcn_mfma_f32_32x32x16_bf16(av[i], bv1[i], acc1, 0, 0, 0); } }
#pragma unroll
        for (int reg = 0; reg < 16; ++reg) { red[(F.wave * 16 + reg) * 64 + F.lane] = acc0[reg]; if (MODE == 2) red[8192 + (F.wave * 16 + reg) * 64 + F.lane] = acc1[reg]; }
        __syncthreads();
#pragma unroll
        for (int oo = 0; oo < 2; ++oo) { const int o = F.tid + NTHR * oo, reg = o >> 6, ln = o & 63; float s0 = 0.f, s1 = 0.f;
#pragma unroll
            for (int w = 0; w < 8; ++w) { s0 += red[(w * 16 + reg) * 64 + ln]; if (MODE == 2) s1 += red[8192 + (w * 16 + reg) * 64 + ln]; }
            const int row = crow(reg, ln >> 5), col = n0 + (ln & 31);
            if (MODE == 0) P.PROJ[(size_t)(MP + row) * INW + col] = s0;
            if (MODE == 2) P.FF[(size_t)(MP + row) * DFF + col] = cvt1(siluf(s0) * s1);
            if (MODE == 1 || MODE == 3) { bf16* xp = P.XB + (size_t)(MP + row) * DM + col; const float x = px[oo] + pg[oo] * s0; *xp = cvt1(x);
                if (MODE == 3 && l == DEPTH - 1) P.out[O_YS + (size_t)row * DM + col] = x; } }
        __syncthreads();
    }
}

typedef float f32x2s __attribute__((ext_vector_type(2)));
struct AsRegs { f32x4 qx[8], kx[8], nx[8]; f32x2s vx[16], vn; };
__device__ __forceinline__ void attn_sample_load(const Frame& F, const Ptrs& P, int l, int it, AsRegs& R) {
    const int b = it >> 3, hq = it & 7, kvh = hq >> 2, row = MP + b, lane = F.lane, wave = F.wave;
    const size_t cbase = (((size_t)l * DB + b) * WIN) * 256 + kvh * HD;
    const int kq = lane >> 2, dq = lane & 3, key = 16 * wave + kq;
    const float* qp = P.PROJ + (size_t)row * INW + C_QA + hq * HD + dq * 32; const float* kp = P.cache_k + cbase + (size_t)key * 256 + dq * 32; const float* np = P.KN + (size_t)row * 256 + kvh * HD + dq * 32;
#pragma unroll
    for (int j = 0; j < 8; ++j) { R.qx[j] = *(const f32x4*)(qp + 4 * j); R.kx[j] = *(const f32x4*)(kp + 4 * j); R.nx[j] = *(const f32x4*)(np + 4 * j); }
#pragma unroll
    for (int j = 0; j < 16; ++j) R.vx[j] = *(const f32x2s*)(P.cache_v + cbase + (size_t)(16 * wave + j) * 256 + 2 * lane);
    R.vn = *(const f32x2s*)(P.PROJ + (size_t)row * INW + C_VA + kvh * HD + 2 * lane);
}
__device__ __forceinline__ void attn_sample(const Frame& F, const Ptrs& P, int l, int it, AsRegs& R) {
    const int b = it >> 3, hq = it & 7, kvh = hq >> 2, row = MP + b, lane = F.lane, wave = F.wave;
    LAS float* sc = (LAS float*)(F.lds + RING_OFF); LAS float* red = sc + 192;
    typedef float f32x2v __attribute__((ext_vector_type(2)));
    const int kq = lane >> 2, dq = lane & 3, key = 16 * wave + kq;
    f32x4 (&qx)[8] = R.qx; f32x4 (&kx)[8] = R.kx; f32x4 (&nx)[8] = R.nx; f32x2s (&vx)[16] = R.vx; const f32x2s vn = R.vn;
    const float slope = exp2f(-(float)(hq + 1)), sink = P.sinks[l * NAH + hq];
    { const float* qn = P.q_norm + l * HD + dq * 32; float ss = 0.f, dk = 0.f, dn = 0.f;
#pragma unroll
      for (int j = 0; j < 8; ++j) { const f32x4 n4 = *(const f32x4*)(qn + 4 * j); const f32x4 qq = qx[j];
          ss += (qq.x * qq.x + qq.y * qq.y) + (qq.z * qq.z + qq.w * qq.w);
          const f32x4 qs = qq * n4; dk += (qs.x * kx[j].x + qs.y * kx[j].y) + (qs.z * kx[j].z + qs.w * kx[j].w); dn += (qs.x * nx[j].x + qs.y * nx[j].y) + (qs.z * nx[j].z + qs.w * nx[j].w); }
      ss += __shfl_xor(ss, 1); ss += __shfl_xor(ss, 2); dk += __shfl_xor(dk, 1); dk += __shfl_xor(dk, 2); dn += __shfl_xor(dn, 1); dn += __shfl_xor(dn, 2);
      const float rs = __builtin_amdgcn_rsqf(ss * (1.f / HD) + EPS) * ATT_SCALE;
      if (dq == 0) sc[key] = dk * rs - slope * (float)(WIN - key);
      if (wave == 0 && lane == 0) sc[WIN] = dn * rs; }
    __syncthreads();
    const float s0 = sc[lane], s1 = sc[64 + lane], s2 = lane == 0 ? sc[WIN] : -1e30f;
    float m = fmaxf(fmaxf(s0, s1), s2);
#pragma unroll
    for (int o = 1; o < 64; o <<= 1) m = fmaxf(m, __shfl_xor(m, o));
    m = fmaxf(m, sink);
    const float inv = __builtin_amdgcn_rcpf(wave_sum(__expf(s0 - m) + __expf(s1 - m) + __expf(s2 - m)) + __expf(sink - m));
    f32x2v acc = (f32x2v){0.f, 0.f};
#pragma unroll
    for (int j = 0; j < 16; ++j) acc += vx[j] * (__expf(sc[16 * wave + j] - m) * inv);
    if (wave == 0) acc += vn * (__expf(sc[WIN] - m) * inv);
    *(LAS f32x2v*)(red + wave * HD + 2 * lane) = acc;
    __syncthreads();
    if (wave == 0) { f32x2v o = (f32x2v){0.f, 0.f};
#pragma unroll
        for (int w = 0; w < 8; ++w) o += *(const LAS f32x2v*)(red + w * HD + 2 * lane);
        *(unsigned*)(P.MIX + (size_t)row * DM + 1024 + hq * HD + 2 * lane) = cvt2(o.x, o.y); }
    __syncthreads();
}

__device__ __forceinline__ int hgrn_unit_of(int it) { const int pm = 4 * (it & 7) + (it >> 6), h = (it >> 3) & 7; return ((pm >> 3) * 8 + h) * 8 + (pm & 7); }
__device__ __forceinline__ int attn_unit_of(int it) { const int pm = 4 * (it & 7) + (it >> 6), q4 = (it >> 4) & 3, kvh = (it >> 3) & 1; return ((pm >> 3) * 32 + (pm & 7) * 4 + q4) * 2 + kvh; }
__device__ __forceinline__ void passA_phase(const Frame& F0, int l) {
    Frame F = fresh(F0);
    const Ptrs P = load_ptrs();
    for (int u = F.bid; u < 256; u += F.G) hgrn_seg<false>(F, P, l, hgrn_unit_of(u));
}
#ifndef MIXDUP
#define MIXDUP 0
#endif
#define REPM(k) for (int repm_ = 0; repm_ < (((MIXDUP) >> (k)) & 1) + 1; ++repm_)
constexpr int CW_SPLIT = 8192;
constexpr int CW_RFLAG = 131072;
__device__ __forceinline__ void split_arrive(const XcdBarrier& b, int gen) {
    asm volatile("s_waitcnt vmcnt(0)" ::: "memory");
    __syncthreads();
    if (threadIdx.x < 64) {
        unsigned rel = 0u; unsigned* ctl = b.bar - CW_BAR;
        if (threadIdx.x == 0) {
            unsigned* c = ctl + CW_SPLIT + 2048 * gen;
            __builtin_amdgcn_s_waitcnt(0);
            const unsigned nloc = b.st[0];
            if (xb_add(&c[64 * b.x], 1u) + 1u == nloc) { __builtin_amdgcn_fence(__ATOMIC_RELEASE, "agent"); asm volatile("s_waitcnt vmcnt(0)" ::: "memory"); rel = 1u; }
        }
        rel = __builtin_amdgcn_readfirstlane(rel);
        unsigned tl = threadIdx.x; asm volatile("" : "+v"(tl));
        if (rel && tl < 16) __hip_atomic_store(&ctl[CW_RFLAG + 128 * (16 * tl + b.x)], (unsigned)gen, __ATOMIC_RELAXED, __HIP_MEMORY_SCOPE_AGENT);
    }
}
__device__ __forceinline__ void split_wait(const XcdBarrier& b, int gen) {
    if (threadIdx.x < 64) {
        const unsigned mask = b.st[2];
        unsigned tl = threadIdx.x; asm volatile("" : "+v"(tl));
        if (tl < 16 && ((mask >> tl) & 1u)) { unsigned* f = b.bar - CW_BAR + CW_RFLAG + 128 * (16 * b.x + tl); XB_SPIN(xb_ld(f) < (unsigned)gen, b.bar); }
        if (threadIdx.x == 0) { __builtin_amdgcn_fence(__ATOMIC_ACQUIRE, "agent"); asm volatile("s_waitcnt vmcnt(0)" ::: "memory"); }
    }
    __syncthreads();
}
__device__ __forceinline__ void mixer_attn(const Frame& F0, int l) {
    REPM(1) { Frame F = fresh(F0); const Ptrs P = load_ptrs(); for (int it = F.bid; it < 256; it += F.G) attn_unit(F, P, l, attn_unit_of(it)); }
}
__device__ __forceinline__ void mixer_rest(const Frame& F0, int l) {
    REPM(0) { Frame F = fresh(F0); const Ptrs P = load_ptrs(); for (int it = F.bid; it < 256; it += F.G) hgrn_seg<true>(F, P, l, hgrn_unit_of(it)); }
    static_assert(DB * NAH == 256, "sample items pair up one to one");
    REPM(2) { Frame F = fresh(F0); const Ptrs P = load_ptrs(); for (int it = F.bid; it < 256; it += F.G) { AsRegs R; attn_sample_load(F, P, l, it, R); hgrn_unit(F, P, l, 32 + it); attn_sample(F, P, l, it, R); } }
}

__global__ void __launch_bounds__(NTHR, 2) fwd(Args a) {
    extern __shared__ __attribute__((aligned(16))) unsigned char lds[];
    Frame F;
    F.lds = (LAS unsigned char*)lds; F.MISC = (volatile LAS unsigned*)(F.lds + MISC_OFF);
    F.tid = threadIdx.x; F.lane = F.tid & 63; F.wave = __builtin_amdgcn_readfirstlane(F.tid >> 6); F.bid = blockIdx.x; F.G = gridDim.x;
    for (int u = F.tid; u < (LDS_BYTES - LDSCTL_OFF) / 4; u += NTHR) ((LAS unsigned*)(F.lds + LDSCTL_OFF))[u] = 0u;
    __syncthreads();
    XcdBarrier bar; bar.bar = (unsigned*)(a.ws + WS_CTL) + CW_BAR; bar.x = 0; bar.st = nullptr;
    if (a.fused) bar = xcd_barrier_post((unsigned*)(a.ws + WS_CTL) + CW_BAR, F.MISC + 8);
#ifndef DUPMASK
#define DUPMASK 0
#endif
#define IN(k) (a.ph_lo <= (k) && (k) < a.ph_hi)
#define REP(k) for (int rep_ = 0; rep_ < (((DUPMASK) >> (k)) & 1) + 1; ++rep_)
#ifdef SEAMDUP
#define SEAM() do { if (a.fused) { xcd_barrier(bar); xcd_barrier(bar); } } while (0)
#else
#define SEAM() do { if (a.fused) xcd_barrier(bar); } while (0)
#endif
    int sgen = 0;
#define SEAMF() do { if (a.fused) { ++sgen; split_arrive(bar, sgen); split_wait(bar, sgen); } } while (0)
    if (IN(0)) REP(0) { p0_prologue(F); SEAM(); }
    if (a.fused) {
        if (F.tid == 0) { unsigned m = 0u;
#pragma unroll
            for (unsigned j = 0; j < 16; ++j) if (xb_ld(&bar.bar[XB_XCNT(j)]) > 0u) m |= 1u << j;
            F.MISC[10] = m; }
        __syncthreads(); }
    for (int l = a.l_lo; l < a.l_hi; ++l) {
        if (IN(1)) REP(1) { norm_phase(F, l, 0); SEAMF(); }
        if (IN(2)) REP(2) { const Ptrs P = load_ptrs(); pg8::Gemm g{P.H, wl_in(P.ws, l), MP, INW, DM}; pg8::StaticOrder S; S.init(MP, INW, F.G, F.bid);
            pg8::EpiInProj E{(bf16*)(P.ws + WS_QL), (bf16*)(P.ws + WS_VL), (bf16*)(P.ws + WS_GL), (float*)(P.ws + WS_FR), (bf16*)(P.ws + WS_QA), (bf16*)(P.ws + WS_KA), (bf16*)(P.ws + WS_VA), P.out + O_VP + (size_t)l * NB * WIN * 256, 0};
#ifdef PROBE_VAT
            if (rep_ == 0 && ((DUPMASK >> 2) & 1)) { pg8::EpiInProj E2 = E; E2.novat = 1; pg8::gemm_phase<pg8::EpiInProj, pg8::StaticOrder, true, true>(F.lds + RING_OFF, g, S, E2); } else
#endif
#ifdef PROBE_EPI
            if (rep_ == 0 && ((DUPMASK >> 2) & 1)) { pg8::EpiProbe EP{(float*)(P.ws + WS_KN)}; pg8::gemm_phase<pg8::EpiProbe, pg8::StaticOrder, true, true>(F.lds + RING_OFF, g, S, EP); } else
#endif
            pg8::gemm_phase<pg8::EpiInProj, pg8::StaticOrder, true, true>(F.lds + RING_OFF, g, S, E); skinny_phase<0>(F, l); tr_rider(F, TR_X + l * I_L, TR_X + l * I_L + TR_S2, (MP / 256) * (INW / 256) % F.G);
            if (a.fused) { ++sgen; split_arrive(bar, sgen); cache_shift(F, l); split_wait(bar, sgen); } else cache_shift(F, l); }
        if (IN(3)) REP(3) { passA_phase(F, l); prep_phase(F, l); if (a.fused) { ++sgen; split_arrive(bar, sgen); } }
        if (IN(4)) REP(4) { mixer_attn(F, l); if (a.fused) split_wait(bar, sgen); mixer_rest(F, l); SEAMF(); }
        if (IN(5)) REP(5) { const Ptrs P = load_ptrs(); const float* modl = P.MOD + (size_t)l * NMOD * MODW; pg8::Gemm g{P.MIX, wl_out(P.ws, l), MP, DM, DM}; pg8::StaticOrder S; S.init(MP, DM, F.G, F.bid);
            pg8::EpiResidB E{l == 0 ? P.x_prompt : nullptr, P.XB, nullptr, modl + 2 * DM, MODW};

#ifdef PROBE_EPI
            if (rep_ == 0 && ((DUPMASK >> 5) & 1)) { pg8::EpiProbe EP{(float*)(P.ws + WS_KN)}; pg8::gemm_phase<pg8::EpiProbe, pg8::StaticOrder, true, true>(F.lds + RING_OFF, g, S, EP); continue; } else
#endif
            pg8::gemm_phase<pg8::EpiResidB, pg8::StaticOrder, true, true>(F.lds + RING_OFF, g, S, E); skinny_phase<1>(F, l); SEAMF(); }
        if (IN(6)) REP(6) { norm_phase(F, l, 1); SEAMF(); }
        if (IN(7)) REP(7) { const Ptrs P = load_ptrs(); pg8::Gemm g{P.H, wl_gu(P.ws, l), MP, 2 * DFF, DM}; pg8::StaticOrder S; S.init(MP, 2 * DFF, F.G, F.bid);
            pg8::EpiSwiglu E{P.FF, DFF};
            pg8::gemm_phase<pg8::EpiSwiglu, pg8::StaticOrder, true, true>(F.lds + RING_OFF, g, S, E); skinny_phase<2>(F, l); tr_rider(F, TR_X + l * I_L + TR_S2, TR_X + (l + 1) * I_L, (MP / 256) * (2 * DFF / 256) % F.G, l + 1 < DEPTH ? (l + 1) * (MODW / 64) + MOD_P0 : 0, l + 1 < DEPTH ? (l + 2) * (MODW / 64) : 0); SEAMF(); }
        if (IN(8)) REP(8) { const Ptrs P = load_ptrs(); const float* modl = P.MOD + (size_t)l * NMOD * MODW; pg8::Gemm g{P.FF, wl_dn(P.ws, l), MP, DM, DFF}; pg8::StaticOrder S; S.init(MP, DM, F.G, F.bid);
            pg8::EpiResidB E{nullptr, P.XB, l == DEPTH - 1 ? P.out : nullptr, modl + 5 * DM, MODW};

#ifdef PROBE_EPI
            if (rep_ == 0 && ((DUPMASK >> 8) & 1)) { pg8::EpiProbe EP{(float*)(P.ws + WS_KN)}; pg8::gemm_phase<pg8::EpiProbe, pg8::StaticOrder, true, true>(F.lds + RING_OFF, g, S, EP); continue; } else
#endif
            pg8::gemm_phase<pg8::EpiResidB, pg8::StaticOrder, true, true>(F.lds + RING_OFF, g, S, E); skinny_phase<3>(F, l); if (l + 1 < a.l_hi) SEAMF(); }
    }
#undef IN
#undef SEAM
}

#ifndef MK_FUSED
#define MK_FUSED 1
#endif
extern "C" void kernel_launch(void* const* d_in, const int* in_sizes, int n_in, void* d_out, int out_size, void* d_ws, size_t ws_size, hipStream_t stream) {
    static int grid = 0;
    if (grid == 0) {
        if (n_in != 21 || (size_t)out_size != O_END || ws_size < WS_END) { fprintf(stderr, "kernel_launch: unexpected shapes: n_in %d out %d (want %zu) ws %zu (want %zu)\n", n_in, out_size, (size_t)O_END, ws_size, (size_t)WS_END); grid = -1; return; }
        int dev = 0, cus = 0, per_cu = 0;
        if (hipGetDevice(&dev) != hipSuccess || hipDeviceGetAttribute(&cus, hipDeviceAttributeMultiprocessorCount, dev) != hipSuccess) { grid = -1; return; }
        if (hipFuncSetAttribute((const void*)fwd, hipFuncAttributeMaxDynamicSharedMemorySize, LDS_BYTES) != hipSuccess) { fprintf(stderr, "kernel_launch: hipFuncSetAttribute failed\n"); grid = -1; return; }
        if (hipOccupancyMaxActiveBlocksPerMultiprocessor(&per_cu, (const void*)fwd, NTHR, LDS_BYTES) != hipSuccess || per_cu < 1) fprintf(stderr, "kernel_launch: occupancy query says %d\n", per_cu);
        (void)hipGetLastError();
        grid = cus;
    }
    if (grid < 0) return;
    if (hipMemsetAsync((char*)d_ws + WS_CTL, 0, CTL_ZERO_BYTES, stream) != hipSuccess) return;
    Args a{};
    for (int i = 0; i < 21; ++i) a.in[i] = (const float*)d_in[i];
    a.out = (float*)d_out; a.ws = (unsigned char*)d_ws;
#if MK_FUSED
    a.l_lo = 0; a.l_hi = DEPTH; a.ph_lo = 0; a.ph_hi = 9; a.fused = 1;
    hipLaunchKernelGGL(fwd, dim3(grid), dim3(NTHR), LDS_BYTES, stream, a);
#else
    a.fused = 0;
    a.l_lo = 0; a.l_hi = 0; a.ph_lo = 0; a.ph_hi = 1;
    hipLaunchKernelGGL(fwd, dim3(grid), dim3(NTHR), LDS_BYTES, stream, a);
    for (int l = 0; l < DEPTH; ++l) for (int ph = 1; ph <= 8; ++ph) { a.l_lo = l; a.l_hi = l + 1; a.ph_lo = ph; a.ph_hi = ph + 1; hipLaunchKernelGGL(fwd, dim3(grid), dim3(NTHR), LDS_BYTES, stream, a); }
#endif
}
```

```cpp
#include <hip/hip_runtime.h>
#include <cstdio>
#include <cstdint>
namespace pg8 {
#define PG8_LAS __attribute__((address_space(3)))
typedef unsigned short bf16_t;
typedef short bf16x8 __attribute__((ext_vector_type(8)));
typedef float f32x4 __attribute__((ext_vector_type(4)));
typedef unsigned u32x4 __attribute__((ext_vector_type(4)));
constexpr int BM = 256, BK = 64, HALF = 128, HTB = HALF * BK * 2  , STAGE_BYTES = 8 * HTB, NXCD = 8, WGM = 4;

__host__ __device__ __forceinline__ int lds_byte(int r, int c) { const int st = (r >> 4) * 2 + (c >> 5), rr = r & 15, cc = c & 31, ob = rr * 64 + cc * 2; return st * 1024 + (ob ^ (((ob >> 9) & 1) << 5)); }
__host__ __device__ __forceinline__ void stage_rc(int b, int& R, int& C) { const int st = b / 1024, sb = b % 1024, swz = sb ^ (((sb >> 9) & 1) << 5); R = (st >> 1) * 16 + swz / 64; C = (st & 1) * 32 + (swz % 64) / 2; }
__host__ __device__ __forceinline__ int perm32(int rho) { const int n = rho >> 4, i = rho & 15; return 8 * (i >> 2) + 4 * n + (i & 3); }

struct Unit { int pm, pn; };
struct Gemm { const bf16_t* A; const bf16_t* Bt; int M, N, K; };

struct StaticOrder {
    int nM, nN, nwg, G, c;
    __host__ __device__ void init(int M, int N, int G_, int c_) { nM = M / BM; nN = N / BM; nwg = nM * nN; G = G_; c = c_; }
    __host__ __device__ bool next(int i, Unit& u) const {
        const long L = (long)i * G + c; if (L >= nwg) return false;
        int wgid = (int)L; { const int q = nwg / NXCD, r = nwg % NXCD, xcd = wgid % NXCD, off = wgid / NXCD; wgid = (xcd < r ? xcd * (q + 1) : r * (q + 1) + (xcd - r) * q) + off; }
        const int nig = WGM * nN, gid = wgid / nig, fm = gid * WGM, gsz = (nM - fm) < WGM ? (nM - fm) : WGM;
        u.pm = fm + ((wgid % nig) % gsz); u.pn = (wgid % nig) / gsz; return true;
    }
    __device__ __forceinline__ void a_ready(const Unit&) const {}
    __device__ __forceinline__ void done(const Unit&) const {}
};

__device__ __forceinline__ unsigned cvt_pk_bf16(float lo, float hi) { unsigned r; asm volatile("v_cvt_pk_bf16_f32 %0, %1, %2" : "=v"(r) : "v"(lo), "v"(hi)); return r; }
typedef float f32x2 __attribute__((ext_vector_type(2)));
__device__ __forceinline__ int mod_row(int r) { return r < 8192 ? (r >> 11) : (r < 8224 ? r - 8192 + 4 : 35); }
struct EpiF32 {
    static constexpr bool PERM = false, AFTER_DRAIN = false;
    float* O; int ldc;
    __device__ __forceinline__ void operator()(const f32x4 (&acc)[2][2][4][2], const Unit& u, int wr, int wc, int fr, int fq) const {
        const int row0 = u.pm * BM + wr * 64 + fr, col0 = u.pn * BM + wc * 32 + 4 * fq;
#pragma unroll
        for (int ai = 0; ai < 2; ++ai)
#pragma unroll
            for (int m = 0; m < 4; ++m) { float* rowp = O + (size_t)(row0 + ai * HALF + m * 16) * ldc + col0;
#pragma unroll
                for (int bj = 0; bj < 2; ++bj)
#pragma unroll
                    for (int n = 0; n < 2; ++n) *(f32x4*)(rowp + bj * HALF + n * 16) = acc[ai][bj][m][n]; }
    }
};
struct EpiResid {
    static constexpr bool PERM = false, AFTER_DRAIN = false;
    const float* Xin; float* Xout; float* Xout2; const float* gate; int ldg;
    __device__ __forceinline__ void operator()(const f32x4 (&acc)[2][2][4][2], const Unit& u, int wr, int wc, int fr, int fq) const {
        const int row0 = u.pm * BM + wr * 64 + fr, col0 = u.pn * BM + wc * 32 + 4 * fq;
        const float* gp = gate + (size_t)(u.pm >> 3) * ldg + col0;
        f32x4 g[2][2];
#pragma unroll
        for (int bj = 0; bj < 2; ++bj)
#pragma unroll
            for (int n = 0; n < 2; ++n) g[bj][n] = *(const f32x4*)(gp + bj * HALF + n * 16);
#pragma unroll
        for (int ai = 0; ai < 2; ++ai)
#pragma unroll
            for (int mp = 0; mp < 2; ++mp) {
                f32x4 xv[2][2][2];
#pragma unroll
                for (int mm = 0; mm < 2; ++mm) { const size_t off = (size_t)(row0 + ai * HALF + (2 * mp + mm) * 16) * 2048 + col0;
#pragma unroll
                    for (int bj = 0; bj < 2; ++bj)
#pragma unroll
                        for (int n = 0; n < 2; ++n) xv[mm][bj][n] = *(const f32x4*)(Xin + off + bj * HALF + n * 16); }
                asm volatile("" ::: "memory");
#pragma unroll
                for (int mm = 0; mm < 2; ++mm) { const int m = 2 * mp + mm; const size_t off = (size_t)(row0 + ai * HALF + m * 16) * 2048 + col0;
#pragma unroll
                    for (int bj = 0; bj < 2; ++bj)
#pragma unroll
                        for (int n = 0; n < 2; ++n) { const f32x4 o = xv[mm][bj][n] + g[bj][n] * acc[ai][bj][m][n]; *(f32x4*)(Xout + off + bj * HALF + n * 16) = o; if (Xout2) *(f32x4*)(Xout2 + off + bj * HALF + n * 16) = o; } }
                asm volatile("" ::: "memory");
            }
    }
};
struct EpiResidB {
    static constexpr bool PERM = true, AFTER_DRAIN = false;
    const float* Xf; bf16_t* Xb; float* Yout; const float* gate; int ldg;
    static __device__ __forceinline__ float lo16(unsigned w) { return __uint_as_float(w << 16); }
    static __device__ __forceinline__ float hi16(unsigned w) { return __uint_as_float(w & 0xffff0000u); }
    __device__ __forceinline__ void operator()(const f32x4 (&acc)[2][2][4][2], const Unit& u, int wr, int wc, int fr, int fq) const {
        const int row0 = u.pm * BM + wr * 64 + fr, col0 = u.pn * BM + wc * 32 + 8 * fq;
        const float* gp = gate + (size_t)(u.pm >> 3) * ldg + col0;
        f32x4 g[2][2];
#pragma unroll
        for (int bj = 0; bj < 2; ++bj)
#pragma unroll
            for (int n = 0; n < 2; ++n) g[bj][n] = *(const f32x4*)(gp + bj * HALF + 4 * n);
        if (!Xf) {
            u32x4 xb[8][2];
#define RB_LOAD(rg) do { const size_t off_ = (size_t)(row0 + ((rg) >> 2) * HALF + ((rg) & 3) * 16) * 2048 + col0; xb[rg][0] = *(const u32x4*)(Xb + off_); xb[rg][1] = *(const u32x4*)(Xb + off_ + HALF); } while (0)
#define RB_DO(rg) do { const int ai_ = (rg) >> 2, m_ = (rg) & 3; const size_t off_ = (size_t)(row0 + ai_ * HALF + m_ * 16) * 2048 + col0; \
                _Pragma("unroll") for (int bj = 0; bj < 2; ++bj) { const u32x4 w = xb[rg][bj]; \
                    const f32x4 x0 = (f32x4){lo16(w.x), hi16(w.x), lo16(w.y), hi16(w.y)}, x1 = (f32x4){lo16(w.z), hi16(w.z), lo16(w.w), hi16(w.w)}; \
                    const f32x4 o0 = x0 + g[bj][0] * acc[ai_][bj][m_][0], o1 = x1 + g[bj][1] * acc[ai_][bj][m_][1]; \
                    if (Yout) { *(f32x4*)(Yout + off_ + bj * HALF) = o0; *(f32x4*)(Yout + off_ + bj * HALF + 4) = o1; } \
                    else { u32x4 v; v.x = cvt_pk_bf16(o0[0], o0[1]); v.y = cvt_pk_bf16(o0[2], o0[3]); v.z = cvt_pk_bf16(o1[0], o1[1]); v.w = cvt_pk_bf16(o1[2], o1[3]); *(u32x4*)(Xb + off_ + bj * HALF) = v; } } } while (0)
            RB_LOAD(0); RB_LOAD(1); RB_LOAD(2); RB_LOAD(3); RB_LOAD(4);
#pragma unroll
            for (int rg = 0; rg < 5; ++rg) asm volatile("" : "+v"(xb[rg][0]), "+v"(xb[rg][1]));
            RB_DO(0); asm volatile("" ::: "memory"); RB_LOAD(5); asm volatile("" ::: "memory");
            RB_DO(1); asm volatile("" ::: "memory"); RB_LOAD(6); asm volatile("" ::: "memory");
            RB_DO(2); asm volatile("" ::: "memory"); RB_LOAD(7); asm volatile("" ::: "memory");
            RB_DO(3); RB_DO(4);
            asm volatile("" : "+v"(xb[5][0]), "+v"(xb[5][1]), "+v"(xb[6][0]), "+v"(xb[6][1]), "+v"(xb[7][0]), "+v"(xb[7][1]));
            RB_DO(5); RB_DO(6); RB_DO(7);
#undef RB_LOAD
#undef RB_DO
            return;
        }
#pragma unroll
        for (int ai = 0; ai < 2; ++ai)
#pragma unroll
            for (int mp = 0; mp < 2; ++mp) {
                f32x4 xv[2][2][2];
#pragma unroll
                for (int mm = 0; mm < 2; ++mm) { const size_t off = (size_t)(row0 + ai * HALF + (2 * mp + mm) * 16) * 2048 + col0;
#pragma unroll
                    for (int bj = 0; bj < 2; ++bj)
#pragma unroll
                        for (int n = 0; n < 2; ++n) xv[mm][bj][n] = *(const f32x4*)(Xf + off + bj * HALF + 4 * n); }
                asm volatile("" ::: "memory");
#pragma unroll
                for (int mm = 0; mm < 2; ++mm) { const int m = 2 * mp + mm; const size_t off = (size_t)(row0 + ai * HALF + m * 16) * 2048 + col0;
#pragma unroll
                    for (int bj = 0; bj < 2; ++bj) { const f32x4 o0 = xv[mm][bj][0] + g[bj][0] * acc[ai][bj][m][0], o1 = xv[mm][bj][1] + g[bj][1] * acc[ai][bj][m][1];
                        if (Yout) { *(f32x4*)(Yout + off + bj * HALF) = o0; *(f32x4*)(Yout + off + bj * HALF + 4) = o1; }
                        else { u32x4 w; w.x = cvt_pk_bf16(o0[0], o0[1]); w.y = cvt_pk_bf16(o0[2], o0[3]); w.z = cvt_pk_bf16(o1[0], o1[1]); w.w = cvt_pk_bf16(o1[2], o1[3]); *(u32x4*)(Xb + off + bj * HALF) = w; } } }
                asm volatile("" ::: "memory");
            }
    }
};
struct EpiSwiglu {
    static constexpr bool PERM = true, AFTER_DRAIN = false;
    bf16_t* O; int ldc;
    __device__ __forceinline__ void operator()(const f32x4 (&acc)[2][2][4][2], const Unit& u, int wr, int wc, int fr, int fq) const {
        const int row0 = u.pm * BM + wr * 64 + fr, col0 = u.pn * HALF + wc * 32 + 8 * fq;
#pragma unroll
        for (int ai = 0; ai < 2; ++ai)
#pragma unroll
            for (int m = 0; m < 4; ++m) { bf16_t* rowp = O + (size_t)(row0 + ai * HALF + m * 16) * ldc + col0;
                float v[8];
#pragma unroll
                for (int n = 0; n < 2; ++n)
#pragma unroll
                    for (int j = 0; j < 4; ++j) { const float g = acc[ai][0][m][n][j], up = acc[ai][1][m][n][j]; v[n * 4 + j] = g * __builtin_amdgcn_rcpf(1.0f + __expf(-g)) * up; }
                u32x4 w; w.x = cvt_pk_bf16(v[0], v[1]); w.y = cvt_pk_bf16(v[2], v[3]); w.z = cvt_pk_bf16(v[4], v[5]); w.w = cvt_pk_bf16(v[6], v[7]);
                *(u32x4*)rowp = w; }
    }
};
struct EpiInProj {
    static constexpr bool PERM = true, AFTER_DRAIN = false;
    bf16_t *QL, *VL, *GL; float* FR; bf16_t *QA, *KA, *VA; float* newv; int novat;
    static __device__ __forceinline__ float silu(float x) { return x * __builtin_amdgcn_rcpf(1.0f + __expf(-x)); }
    static __device__ __forceinline__ u32x4 pack8(const f32x4& a, const f32x4& b) { u32x4 w; w.x = cvt_pk_bf16(a[0], a[1]); w.y = cvt_pk_bf16(a[2], a[3]); w.z = cvt_pk_bf16(b[0], b[1]); w.w = cvt_pk_bf16(b[2], b[3]); return w; }
    __device__ __forceinline__ void operator()(const f32x4 (&acc)[2][2][4][2], const Unit& u, int wr, int wc, int fr, int fq) const {
        const int row0 = u.pm * BM + wr * 64 + fr, d0 = wc * 32 + 8 * fq;
        if (u.pn < 16) {
            const int T = u.pn >> 2;
            if (T == 1) {
#pragma unroll
                for (int bj = 0; bj < 2; ++bj) { const int head = 2 * (u.pn & 3) + bj;
#pragma unroll
                    for (int ai = 0; ai < 2; ++ai)
#pragma unroll
                        for (int m = 0; m < 4; ++m) { const size_t idx = ((size_t)head * 8448 + row0 + ai * HALF + m * 16) * 128 + d0; *(f32x4*)(FR + idx) = acc[ai][bj][m][0]; *(f32x4*)(FR + idx + 4) = acc[ai][bj][m][1]; } }
            } else if (T == 2) {
#pragma unroll
                for (int bj = 0; bj < 2; ++bj) { const int head = 2 * (u.pn & 3) + bj;
#pragma unroll
                    for (int ai = 0; ai < 2; ++ai)
#pragma unroll
                        for (int m = 0; m < 4; ++m) { const size_t idx = ((size_t)head * 8448 + row0 + ai * HALF + m * 16) * 128 + d0; *(u32x4*)(VL + idx) = pack8(acc[ai][bj][m][0], acc[ai][bj][m][1]); } }
            } else {
                bf16_t* dst = T == 0 ? QL : GL;
#pragma unroll
                for (int bj = 0; bj < 2; ++bj) { const int head = 2 * (u.pn & 3) + bj;
#pragma unroll
                    for (int ai = 0; ai < 2; ++ai)
#pragma unroll
                        for (int m = 0; m < 4; ++m) { const size_t idx = ((size_t)head * 8448 + row0 + ai * HALF + m * 16) * 128 + d0; f32x4 v0 = acc[ai][bj][m][0], v1 = acc[ai][bj][m][1];
#pragma unroll
                            for (int j = 0; j < 4; ++j) { v0[j] = silu(v0[j]); v1[j] = silu(v1[j]); }
                            *(u32x4*)(dst + idx) = pack8(v0, v1); } }
            }
        } else {
            bf16_t* dst = QA + (u.pn < 20 ? (size_t)0 : (size_t)8448 * 1024 + (size_t)(u.pn - 20) * ((size_t)8448 * 256)); const int ld = u.pn < 20 ? 1024 : 256, c0 = (u.pn < 20 ? (u.pn - 16) * 256 : 0) + d0;
#pragma unroll
            for (int bj = 0; bj < 2; ++bj)
#pragma unroll
                for (int ai = 0; ai < 2; ++ai)
#pragma unroll
                    for (int m = 0; m < 4; ++m) *(u32x4*)(dst + (size_t)(row0 + ai * HALF + m * 16) * ld + c0 + bj * HALF) = pack8(acc[ai][bj][m][0], acc[ai][bj][m][1]);
        }
        if (u.pn == 21) { const int b = u.pm >> 3;
            if ((u.pm & 7) == 7) {
#pragma unroll
                for (int bj = 0; bj < 2; ++bj)
#pragma unroll
                    for (int m = 0; m < 4; ++m) { float* np = newv + ((size_t)b * 128 + wr * 64 + m * 16 + fr) * 256 + bj * HALF + d0; *(f32x4*)np = acc[1][bj][m][0]; *(f32x4*)(np + 4) = acc[1][bj][m][1]; } }
        }
    }
};
struct EpiProbe {
    static constexpr bool PERM = true, AFTER_DRAIN = false;
    float* sink;
    __device__ __forceinline__ void operator()(const f32x4 (&acc)[2][2][4][2], const Unit& u, int wr, int wc, int fr, int fq) const {
        f32x4 t = (f32x4){0.f, 0.f, 0.f, 0.f};
#pragma unroll
        for (int ai = 0; ai < 2; ++ai)
#pragma unroll
            for (int bj = 0; bj < 2; ++bj)
#pragma unroll
                for (int m = 0; m < 4; ++m)
#pragma unroll
                    for (int n = 0; n < 2; ++n) t += acc[ai][bj][m][n];
        if (t[0] + t[1] + t[2] + t[3] == 123456.789f) sink[u.pm * 22 + u.pn] = t[0];
    }
};
template <class Epi, class Sched, bool ALIGN_EPI = false, bool SP2 = false>
__device__ __forceinline__ void gemm_phase(PG8_LAS unsigned char* lds, const Gemm g, const Sched& S, const Epi& E) {
    int tid_ = threadIdx.x; asm volatile("" : "+v"(tid_));
    const int tid = tid_, wid = __builtin_amdgcn_readfirstlane(tid >> 6), lane = tid & 63, wr = wid >> 2, wc = wid & 3, fr = lane & 15, fq = lane >> 4;
    const int K = g.K, nt = K / BK;
    unsigned voffA[2], voffB[2];
#pragma unroll
    for (int i = 0; i < 2; ++i) { int R, C; stage_rc(tid * 16 + i * 8192, R, C); const int Rb = Epi::PERM ? ((R & ~31) + perm32(R & 31)) : R;
        voffA[i] = (unsigned)(R * K + C) * 2u; voffB[i] = (unsigned)(Rb * K + C) * 2u; }
    const size_t kstep = (size_t)(BK * 2);
    const size_t hstep = (size_t)HALF * K * 2;
    const size_t tstep = 2 * hstep;
    const unsigned ldsw = (unsigned)wid * 1024u;
    const int aoff = lds_byte(wr * 64 + fr, fq * 8), boff = lds_byte(wc * 32 + fr, fq * 8);
#define PG8_SA(b, h) (((b) * 2 + (h)) * HTB)
#define PG8_SB(b, h) ((4 + (b) * 2 + (h)) * HTB)
#define PG8_STAGE(bufoff, gbase, voff) do { _Pragma("unroll") for (int _i = 0; _i < 2; ++_i) \
        __builtin_amdgcn_global_load_lds((const unsigned*)((const char*)(gbase) + (voff)[_i]), (PG8_LAS unsigned*)(lds + (bufoff) + ldsw + _i * 8192), 16, 0, 0); } while (0)
#define PG8_LDA(dst, b, h) do { _Pragma("unroll") for (int m = 0; m < 4; ++m) _Pragma("unroll") for (int k = 0; k < 2; ++k) dst[m][k] = *(const PG8_LAS bf16x8*)(lds + PG8_SA(b, h) + aoff + m * 2048 + k * 1024); } while (0)
#define PG8_LDB(dst, b, h) do { _Pragma("unroll") for (int n = 0; n < 2; ++n) _Pragma("unroll") for (int k = 0; k < 2; ++k) dst[n][k] = *(const PG8_LAS bf16x8*)(lds + PG8_SB(b, h) + boff + n * 2048 + k * 1024); } while (0)
#define PG8_MMA(ai, bj, At, Bt) do { __builtin_amdgcn_s_setprio(1); _Pragma("unroll") for (int m = 0; m < 4; ++m) _Pragma("unroll") for (int n = 0; n < 2; ++n) _Pragma("unroll") for (int k = 0; k < 2; ++k) \
        acc[ai][bj][m][n] = __builtin_amdgcn_mfma_f32_16x16x32_bf16(Bt[n][k], At[m][k], acc[ai][bj][m][n], 0, 0, 0); __builtin_amdgcn_s_setprio(0); } while (0)
#define PG8_WAIT_V(n) asm volatile("s_waitcnt vmcnt(" #n ")" ::: "memory")
#define PG8_WAIT_L(n) asm volatile("s_waitcnt lgkmcnt(" #n ")" ::: "memory")
#define PG8_BAR __builtin_amdgcn_s_barrier()
#define PG8_SCHED __builtin_amdgcn_sched_barrier(0)
    Unit cur, nxt; int ui = 0;
    if (!S.next(0, cur)) return;
    f32x4 acc[2][2][4][2];
#pragma unroll
    for (int a = 0; a < 2; ++a)
#pragma unroll
        for (int b = 0; b < 2; ++b)
#pragma unroll
            for (int m = 0; m < 4; ++m)
#pragma unroll
                for (int n = 0; n < 2; ++n) acc[a][b][m][n] = (f32x4){0.f, 0.f, 0.f, 0.f};
    bf16x8 At[4][2], B0[2][2], B1[2][2];
    const char* cA = (const char*)g.A + (size_t)cur.pm * tstep; const char* cB = (const char*)g.Bt + (size_t)cur.pn * tstep;
    S.a_ready(cur);
    if constexpr (SP2) {
        PG8_STAGE(PG8_SB(0, 0), cB, voffB); PG8_STAGE(PG8_SB(0, 1), cB + hstep, voffB); PG8_STAGE(PG8_SA(0, 0), cA, voffA); PG8_STAGE(PG8_SA(0, 1), cA + hstep, voffA);
        if (wr == 1) PG8_BAR;
        PG8_WAIT_V(2); PG8_BAR;
        PG8_STAGE(PG8_SB(1, 0), cB + kstep, voffB); PG8_STAGE(PG8_SA(1, 0), cA + kstep, voffA); PG8_STAGE(PG8_SB(1, 1), cB + hstep + kstep, voffB);
        PG8_WAIT_V(6); PG8_BAR;
    } else {
        PG8_STAGE(PG8_SB(0, 0), cB, voffB); PG8_STAGE(PG8_SA(0, 0), cA, voffA); PG8_STAGE(PG8_SB(0, 1), cB + hstep, voffB); PG8_STAGE(PG8_SA(0, 1), cA + hstep, voffA);
        if (wr == 1) PG8_BAR;
        PG8_WAIT_V(4); PG8_BAR;
        PG8_STAGE(PG8_SB(1, 0), cB + kstep, voffB); PG8_STAGE(PG8_SA(1, 0), cA + kstep, voffA); PG8_STAGE(PG8_SB(1, 1), cB + hstep + kstep, voffB);
        PG8_WAIT_V(6); PG8_BAR;
    }
    for (;;) {
        const bool has_next = S.next(ui + 1, nxt);
        const char* nA = has_next ? (const char*)g.A + (size_t)nxt.pm * tstep : cA; const char* nB = has_next ? (const char*)g.Bt + (size_t)nxt.pn * tstep : cB;
        for (int t = 0; t < nt; t += 2) {
            const bool last = (t == nt - 2);
            const char* a1 = cA + (size_t)(t + 1) * kstep;
            const char* a2 = last ? nA : cA + (size_t)(t + 2) * kstep; const char* b2 = last ? nB : cB + (size_t)(t + 2) * kstep;
            const char* a3 = a2 + kstep; const char* b3 = b2 + kstep;
            if (last && has_next) S.a_ready(nxt);
            if constexpr (SP2) {
            PG8_LDB(B0, 0, 0); PG8_LDB(B1, 0, 1); PG8_SCHED; PG8_LDA(At, 0, 0); PG8_STAGE(PG8_SA(1, 1), a1 + hstep, voffA);
            PG8_WAIT_V(8); PG8_WAIT_L(0); PG8_BAR; PG8_MMA(0, 0, At, B0); PG8_MMA(0, 1, At, B1); PG8_BAR; PG8_SCHED;
            PG8_LDA(At, 0, 1); PG8_STAGE(PG8_SB(0, 0), b2, voffB); PG8_STAGE(PG8_SB(0, 1), b2 + hstep, voffB); PG8_STAGE(PG8_SA(0, 0), a2, voffA);
            PG8_WAIT_V(8); PG8_WAIT_L(0); PG8_BAR; PG8_MMA(1, 0, At, B0); PG8_MMA(1, 1, At, B1); PG8_BAR; PG8_SCHED;
            PG8_LDB(B0, 1, 0); PG8_LDB(B1, 1, 1); PG8_SCHED; PG8_LDA(At, 1, 0); PG8_STAGE(PG8_SA(0, 1), a2 + hstep, voffA);
            PG8_WAIT_V(8); PG8_WAIT_L(0); PG8_BAR; PG8_MMA(0, 0, At, B0); PG8_MMA(0, 1, At, B1); PG8_BAR; PG8_SCHED;
            PG8_LDA(At, 1, 1); PG8_STAGE(PG8_SB(1, 0), b3, voffB); PG8_STAGE(PG8_SB(1, 1), b3 + hstep, voffB); PG8_STAGE(PG8_SA(1, 0), a3, voffA);
            PG8_WAIT_V(8); PG8_WAIT_L(0); PG8_BAR; PG8_MMA(1, 0, At, B0); PG8_MMA(1, 1, At, B1); PG8_BAR; PG8_SCHED;
            } else {
            PG8_LDB(B0, 0, 0); PG8_SCHED; PG8_LDA(At, 0, 0); PG8_STAGE(PG8_SA(1, 1), a1 + hstep, voffA);
            PG8_WAIT_L(8); PG8_BAR; PG8_WAIT_L(0); PG8_MMA(0, 0, At, B0); PG8_BAR; PG8_SCHED;
            PG8_LDB(B1, 0, 1); PG8_STAGE(PG8_SB(0, 0), b2, voffB);
            PG8_BAR; PG8_WAIT_L(0); PG8_MMA(0, 1, At, B1); PG8_BAR;
            PG8_LDA(At, 0, 1); PG8_STAGE(PG8_SA(0, 0), a2, voffA);
            PG8_BAR; PG8_WAIT_L(0); PG8_MMA(1, 0, At, B0); PG8_BAR; PG8_SCHED;
            PG8_STAGE(PG8_SB(0, 1), b2 + hstep, voffB);
            PG8_WAIT_V(6); PG8_BAR; PG8_MMA(1, 1, At, B1); PG8_BAR;
            PG8_LDB(B0, 1, 0); PG8_SCHED; PG8_LDA(At, 1, 0); PG8_STAGE(PG8_SA(0, 1), a2 + hstep, voffA);
            PG8_WAIT_L(8); PG8_BAR; PG8_WAIT_L(0); PG8_MMA(0, 0, At, B0); PG8_BAR; PG8_SCHED;
            PG8_LDB(B1, 1, 1); PG8_STAGE(PG8_SB(1, 0), b3, voffB);
            PG8_BAR; PG8_WAIT_L(0); PG8_MMA(0, 1, At, B1); PG8_BAR;
            PG8_LDA(At, 1, 1); PG8_STAGE(PG8_SA(1, 0), a3, voffA);
            PG8_BAR; PG8_WAIT_L(0); PG8_MMA(1, 0, At, B0); PG8_BAR; PG8_SCHED;
            PG8_STAGE(PG8_SB(1, 1), b3 + hstep, voffB);
            PG8_WAIT_V(6); PG8_BAR; PG8_MMA(1, 1, At, B1); PG8_BAR;
            }
        }
        if constexpr (ALIGN_EPI) { if (wr == 0) PG8_BAR; }
        if constexpr (!Epi::AFTER_DRAIN) { E(acc, cur, wr, wc, fr, fq); S.done(cur); }
        if (!has_next) break;
#pragma unroll
        for (int a = 0; a < 2; ++a)
#pragma unroll
            for (int b = 0; b < 2; ++b)
#pragma unroll
                for (int m = 0; m < 4; ++m)
#pragma unroll
                    for (int n = 0; n < 2; ++n) acc[a][b][m][n] = (f32x4){0.f, 0.f, 0.f, 0.f};
        cur = nxt; cA = nA; cB = nB; ++ui;
        if constexpr (ALIGN_EPI) { if (wr == 1) PG8_BAR; }
    }
    PG8_WAIT_V(0);
    if constexpr (!ALIGN_EPI) { if (wr == 0) PG8_BAR; }
    PG8_BAR;
    if constexpr (Epi::AFTER_DRAIN) { E.fused(acc, cur, wr, wc, fr, fq, lds, wid, lane); S.done(cur); }
#undef PG8_SA
#undef PG8_SB
#undef PG8_STAGE
#undef PG8_LDA
#undef PG8_LDB
#undef PG8_MMA
#undef PG8_WAIT_V
#undef PG8_WAIT_L
#undef PG8_BAR
#undef PG8_SCHED
}
}
#define GAS __attribute__((address_space(1)))
#define LAS __attribute__((address_space(3)))
typedef unsigned short bf16;
typedef unsigned v4u __attribute__((ext_vector_type(4)));
typedef float f32x4 __attribute__((ext_vector_type(4)));
typedef short bf16x8 __attribute__((ext_vector_type(8)));
typedef GAS unsigned gu32;
typedef GAS unsigned long long gu64;
#define RLX_AGENT __ATOMIC_RELAXED, __HIP_MEMORY_SCOPE_AGENT
#define LDS_WAIT() asm volatile("s_waitcnt lgkmcnt(0)" ::: "memory")
#define VM_WAIT() asm volatile("s_waitcnt vmcnt(0)" ::: "memory")
__device__ __forceinline__ unsigned long long rt() { return __builtin_amdgcn_s_memrealtime(); }
__device__ __forceinline__ unsigned f2bf(float f) { unsigned u = __builtin_bit_cast(unsigned, f); return (u + 0x7fffu + ((u >> 16) & 1u)) >> 16; }
__device__ __forceinline__ unsigned pk2(float lo, float hi) { return f2bf(lo) | (f2bf(hi) << 16); }

#define XB_TMO      128
#define XB_XCNT(j)  (256  + 64 * (j))
#define XB_XSUB(j)  (1280 + 64 * (j))
#define XB_XGEN(j)  (2304 + 64 * (j))
#define XB_TOP      3328
#define XB_TOPGEN   3392
#define XCD_BAR_WORDS 3456
#define XB_SPIN_CAP (1u << 18)

__device__ __forceinline__ unsigned xb_ld(unsigned* p)              { return __hip_atomic_load(p, __ATOMIC_RELAXED, __HIP_MEMORY_SCOPE_AGENT); }
__device__ __forceinline__ unsigned xb_add(unsigned* p, unsigned v) { return __hip_atomic_fetch_add(p, v, __ATOMIC_RELAXED, __HIP_MEMORY_SCOPE_AGENT); }
__device__ __forceinline__ unsigned xb_xcc_id() { return (unsigned)__builtin_amdgcn_s_getreg((3 << 11) | 20) & 0xFu; }
#define XB_SPIN(cond, bar) do { unsigned _sp = 0; while (cond) { __builtin_amdgcn_s_sleep(1); \
    if ((++_sp & 255u) == 0u) { if (xb_ld(&(bar)[XB_TMO])) break; if (_sp > XB_SPIN_CAP) { atomicAdd(&(bar)[XB_TMO], 1u); break; } } } } while (0)

struct XcdBarrier {
    unsigned* bar; unsigned x;
    volatile LAS unsigned* st;
};

__device__ __forceinline__ XcdBarrier xcd_barrier_post(unsigned* bar, volatile LAS unsigned* st) {
    XcdBarrier b; b.bar = bar; b.x = xb_xcc_id(); b.st = st;
    if (threadIdx.x == 0) (void)xb_add(&bar[XB_XCNT(b.x)], 1u);
    return b;
}
__device__ __forceinline__ void xcd_barrier_complete(unsigned* bar, unsigned x, unsigned& nloc, unsigned& nx) {
    const unsigned G = gridDim.x * gridDim.y * gridDim.z;
    unsigned sum, cnt, mine, sp = 0u;
    for (;;) {
        sum = 0u; cnt = 0u; mine = 0u;
#pragma unroll
        for (unsigned j = 0; j < 16; ++j) { const unsigned c = xb_ld(&bar[XB_XCNT(j)]); sum += c; cnt += (c > 0u) ? 1u : 0u; mine = (j == x) ? c : mine; }
        if (sum == G) break;
        __builtin_amdgcn_s_sleep(1);
        if ((++sp & 255u) == 0u) { if (xb_ld(&bar[XB_TMO])) break; if (sp > XB_SPIN_CAP) { atomicAdd(&bar[XB_TMO], 1u); break; } }
    }
    nloc = mine > 0u ? mine : 1u; nx = cnt > 0u ? cnt : 1u;
}

__device__ __forceinline__ void xcd_barrier(const XcdBarrier& b) {
    asm volatile("s_waitcnt vmcnt(0)" ::: "memory");
    __syncthreads();
    if (threadIdx.x == 0) {
        unsigned* bar = b.bar;
        __builtin_amdgcn_s_waitcnt(0);
        unsigned nloc = b.st[0], nx = b.st[1];
        if (nloc == 0u) { xcd_barrier_complete(bar, b.x, nloc, nx); b.st[0] = nloc; b.st[1] = nx; }
        const unsigned old = xb_add(&bar[XB_XSUB(b.x)], 1u);
        const unsigned gen = old / nloc;
        if (old + 1u == (gen + 1u) * nloc) {
            __builtin_amdgcn_fence(__ATOMIC_RELEASE, "agent");
            asm volatile("s_waitcnt vmcnt(0)" ::: "memory");
            const unsigned og = xb_add(&bar[XB_TOP], 1u);
            const unsigned tg = og / nx;
            if (og + 1u == (tg + 1u) * nx) xb_add(&bar[XB_TOPGEN], 1u);
            else XB_SPIN(xb_ld(&bar[XB_TOPGEN]) == tg, bar);
            __builtin_amdgcn_fence(__ATOMIC_ACQUIRE, "agent");
            xb_add(&bar[XB_XGEN(b.x)], 1u);
            asm volatile("s_waitcnt vmcnt(0)" ::: "memory");
        } else {
            XB_SPIN(xb_ld(&bar[XB_XGEN(b.x)]) == gen, bar);
            __builtin_amdgcn_fence(__ATOMIC_ACQUIRE, "agent");
            asm volatile("s_waitcnt vmcnt(0)" ::: "memory");
        }
    }
    __syncthreads();
}
constexpr int NWAVES = 8, NTHR = 512;
constexpr int DM = 2048, NB = 4, SEQ = 2048, DEPTH = 4, DB = 32, HD = 128, NLH = 8, NAH = 8, NKV = 2, WIN = 128;
constexpr int DFF = 5632, INW = 5632;
constexpr int MP = NB * SEQ, MS = DB, MV = MP + MS, MPAD = 8448;
constexpr int NMOD = NB + DB;
constexpr int MODW = 6 * DM;
constexpr float EPS = 1e-6f;
constexpr float ATT_SCALE = 0.08838834764831845f;
constexpr int C_QL = 0, C_FL = 1024, C_IL = 2048, C_GL = 3072, C_QA = 4096, C_KA = 5120, C_VA = 5376;
constexpr size_t O_YP = 0, O_YS = O_YP + (size_t)MP * DM, O_KP = O_YS + (size_t)MS * DM, O_VP = O_KP + (size_t)DEPTH * NB * WIN * 256,
                 O_SP = O_VP + (size_t)DEPTH * NB * WIN * 256, O_KS = O_SP + (size_t)DEPTH * NB * NLH * HD * HD, O_VS = O_KS + (size_t)DEPTH * DB * WIN * 256,
                 O_SS = O_VS + (size_t)DEPTH * DB * WIN * 256, O_END = O_SS + (size_t)DEPTH * DB * NLH * HD * HD;
constexpr size_t MiB = 1u << 20;
constexpr size_t WS_CTL = 0, CTL_ZERO_BYTES = 1 * MiB;
constexpr size_t SZ_WIN = (size_t)INW * DM * 2, SZ_WOUT = (size_t)DM * DM * 2, SZ_WGU = (size_t)2 * DFF * DM * 2, SZ_WDN = (size_t)DM * DFF * 2;
constexpr size_t SZ_WL = SZ_WIN + SZ_WOUT + SZ_WGU + SZ_WDN;
constexpr size_t WS_W = 2 * MiB;
constexpr size_t WS_MOD = WS_W + DEPTH * SZ_WL;
constexpr size_t WS_LB = WS_MOD + (size_t)DEPTH * NMOD * MODW * 4;
constexpr size_t WS_X = WS_LB + 64 * 1024;
constexpr size_t WS_H = WS_X + (size_t)MPAD * DM * 4;
constexpr size_t WS_PROJ = WS_H + (size_t)MPAD * DM * 2;
constexpr size_t WS_KN = WS_PROJ + (size_t)MPAD * INW * 4;
constexpr size_t WS_MIX = WS_KN + (size_t)MPAD * 256 * 4;
constexpr size_t WS_FF = WS_MIX + (size_t)MPAD * DM * 2;
constexpr size_t WS_U = WS_FF + (size_t)MPAD * DFF * 2;
constexpr size_t WS_DG = WS_U + (size_t)256 * HD * HD * 4;
constexpr size_t WS_QL = WS_DG + (size_t)256 * HD * 4;
constexpr size_t WS_VL = WS_QL + (size_t)8 * MPAD * HD * 2;
constexpr size_t WS_GL = WS_VL + (size_t)8 * MPAD * HD * 2;
constexpr size_t WS_FR = WS_GL + (size_t)8 * MPAD * HD * 2;
constexpr size_t WS_QA = WS_FR + (size_t)8 * MPAD * HD * 4;
constexpr size_t WS_KA = WS_QA + (size_t)MPAD * 1024 * 2;
constexpr size_t WS_VA = WS_KA + (size_t)MPAD * 256 * 2;
constexpr size_t WS_END = WS_VA + (size_t)MPAD * 256 * 2;
constexpr int CW_TMO = 0, CW_BAR = 4096;
constexpr int RING_OFF = 0, RING_BYTES = 131072;
constexpr int LDSCTL_OFF = RING_BYTES, MISC_OFF = LDSCTL_OFF + 320;
constexpr int LDS_BYTES = 147456;

struct Args { const float* in[21]; float* out; unsigned char* ws; int l_lo, l_hi, ph_lo, ph_hi, fused, pad; };

__device__ __forceinline__ float dpp_add(float v, float contrib) { return v + contrib; }
#define WS_DPP(v, ctrl, rmask) __builtin_bit_cast(float, __builtin_amdgcn_update_dpp(0, __builtin_bit_cast(int, (v)), (ctrl), (rmask), 0xF, false))
__device__ __forceinline__ float wave_sum(float v) {
    v += WS_DPP(v, 0xB1, 0xF);
    v += WS_DPP(v, 0x4E, 0xF);
    v += WS_DPP(v, 0x141, 0xF);
    v += WS_DPP(v, 0x140, 0xF);
    v += WS_DPP(v, 0x142, 0xA);
    v += WS_DPP(v, 0x143, 0xC);
    return __builtin_bit_cast(float, __builtin_amdgcn_readlane(__builtin_bit_cast(int, v), 63));
}
__device__ __forceinline__ float row16_sum(float v) {
    v += WS_DPP(v, 0xB1, 0xF); v += WS_DPP(v, 0x4E, 0xF); v += WS_DPP(v, 0x141, 0xF); v += WS_DPP(v, 0x140, 0xF);
    return v;
}
__device__ __forceinline__ float siluf(float x) { return x * __builtin_amdgcn_rcpf(1.0f + __expf(-x)); }
typedef float f32x16 __attribute__((ext_vector_type(16)));
typedef __bf16 bf16x2_t __attribute__((ext_vector_type(2)));
typedef float f32x2_t __attribute__((ext_vector_type(2)));
__device__ __forceinline__ unsigned cvt2(float lo, float hi) { f32x2_t v = {lo, hi}; bf16x2_t b = __builtin_convertvector(v, bf16x2_t); return __builtin_bit_cast(unsigned, b); }
__device__ __forceinline__ f32x16 zero16() { f32x16 z;
#pragma unroll
    for (int i = 0; i < 16; ++i) z[i] = 0.f;
    return z; }

struct TrItem { const float* src; bf16* dst; int K, N; };
__device__ __forceinline__ void tr_load(const TrItem& t, float (&wv)[32], int lane) {
    const float* p = t.src + (size_t)(lane >> 5) * t.N + (lane & 31);
#pragma unroll
    for (int i = 0; i < 32; ++i) wv[i] = __builtin_nontemporal_load(p + (size_t)(2 * i) * t.N);
}
__device__ __forceinline__ void tr_process(const TrItem& t, const float (&wv)[32], LAS float* scr, int lane) {
#pragma unroll
    for (int i = 0; i < 32; ++i) scr[(2 * i + (lane >> 5)) * 33 + (lane & 31)] = wv[i];
    LDS_WAIT(); asm volatile("" ::: "memory");
    const int c = lane & 7;
#pragma unroll
    for (int j = 0; j < 4; ++j) { const int n = (lane >> 3) + 8 * j; const LAS float* s = scr + (8 * c) * 33 + n;
        v4u o; o.x = cvt2(s[0 * 33], s[1 * 33]); o.y = cvt2(s[2 * 33], s[3 * 33]); o.z = cvt2(s[4 * 33], s[5 * 33]); o.w = cvt2(s[6 * 33], s[7 * 33]);
        __builtin_nontemporal_store(o, (GAS v4u*)(t.dst + (size_t)n * t.K + 8 * c)); }
    LDS_WAIT(); asm volatile("" ::: "memory");
}

struct Frame {
    LAS unsigned char* lds; volatile LAS unsigned* MISC;
    int tid, lane, wave, bid, G;
};
typedef __attribute__((address_space(4))) const unsigned char* kargp_t;
__device__ __forceinline__ kargp_t karg_base() { kargp_t p = (kargp_t)__builtin_amdgcn_kernarg_segment_ptr(); asm volatile("" : "+s"(p)); return p; }
__device__ __forceinline__ const float* karg_in(int k) { return *(const float* __attribute__((address_space(4))) const*)(karg_base() + 8 * k); }
__device__ __forceinline__ float* karg_out() { return *(float* __attribute__((address_space(4))) const*)(karg_base() + 8 * 21); }
__device__ __forceinline__ unsigned char* karg_ws() { return *(unsigned char* __attribute__((address_space(4))) const*)(karg_base() + 8 * 22); }
enum { I_XP = 0, I_XS, I_CK, I_CV, I_ST, I_CP, I_CS, I_LBND, I_WADA, I_BADA, I_NMIX, I_WIN, I_QN, I_KNRM, I_SINK, I_GN, I_WOUT, I_NFFN, I_WG, I_WU, I_WD };
struct Ptrs {
    const float *x_prompt, *x_sample, *cache_k, *cache_v, *state, *c_prompt, *c_sample, *lower_bounds, *w_ada, *b_ada, *norm_mix, *w_in, *q_norm, *k_norm, *sinks, *g_norm, *w_out, *norm_ffn, *w_gate, *w_up, *w_down;
    float* out; unsigned char* ws; gu32* ctl;
    float *MOD, *LB, *PROJ, *KN; bf16 *XB, *H, *MIX, *FF;
};
__device__ __forceinline__ Ptrs load_ptrs() {
    kargp_t kb = karg_base(); Ptrs P;
#define KIN(k) (*(const float* __attribute__((address_space(4))) const*)(kb + 8 * (k)))
    P.x_prompt = KIN(0); P.x_sample = KIN(1); P.cache_k = KIN(2); P.cache_v = KIN(3); P.state = KIN(4); P.c_prompt = KIN(5); P.c_sample = KIN(6); P.lower_bounds = KIN(7);
    P.w_ada = KIN(8); P.b_ada = KIN(9); P.norm_mix = KIN(10); P.w_in = KIN(11); P.q_norm = KIN(12); P.k_norm = KIN(13); P.sinks = KIN(14); P.g_norm = KIN(15);
    P.w_out = KIN(16); P.norm_ffn = KIN(17); P.w_gate = KIN(18); P.w_up = KIN(19); P.w_down = KIN(20);
#undef KIN
    P.out = *(float* __attribute__((address_space(4))) const*)(kb + 8 * 21); P.ws = *(unsigned char* __attribute__((address_space(4))) const*)(kb + 8 * 22);
    P.ctl = (gu32*)(P.ws + WS_CTL);
    P.MOD = (float*)(P.ws + WS_MOD); P.LB = (float*)(P.ws + WS_LB); P.XB = (bf16*)(P.ws + WS_X); P.PROJ = (float*)(P.ws + WS_PROJ); P.KN = (float*)(P.ws + WS_KN);
    P.H = (bf16*)(P.ws + WS_H); P.MIX = (bf16*)(P.ws + WS_MIX); P.FF = (bf16*)(P.ws + WS_FF);
    return P;
}
__device__ __forceinline__ Frame fresh(const Frame& F0) {
    Frame F = F0; int t = threadIdx.x, b = blockIdx.x, g = gridDim.x; asm volatile("" : "+v"(t)); asm volatile("" : "+s"(b), "+s"(g));
    F.tid = t; F.lane = t & 63; F.wave = __builtin_amdgcn_readfirstlane(t >> 6); F.bid = b; F.G = g; return F;
}
__device__ __forceinline__ bf16* wl_in(unsigned char* ws, int l)  { return (bf16*)(ws + WS_W + (size_t)l * SZ_WL); }
__device__ __forceinline__ bf16* wl_out(unsigned char* ws, int l) { return (bf16*)(ws + WS_W + (size_t)l * SZ_WL + SZ_WIN); }
__device__ __forceinline__ bf16* wl_gu(unsigned char* ws, int l)  { return (bf16*)(ws + WS_W + (size_t)l * SZ_WL + SZ_WIN + SZ_WOUT); }
__device__ __forceinline__ bf16* wl_dn(unsigned char* ws, int l)  { return (bf16*)(ws + WS_W + (size_t)l * SZ_WL + SZ_WIN + SZ_WOUT + SZ_WGU); }

__device__ __forceinline__ void mod_items(const Frame& F, const Ptrs& P, int first, int last, int bid0, int stride, bool stage = true) {
    { LAS float* cpl = (LAS float*)(F.lds + RING_OFF);
      LAS float* red = (LAS float*)(F.lds + RING_OFF + 32768);
      if (stage) { for (int e = F.tid; e < DM * NB; e += NTHR) cpl[e] = siluf(P.c_prompt[(e & 3) * DM + (e >> 2)]);
          __syncthreads(); }
      const int strip = F.wave & 1, kq = F.wave >> 1, hh = F.lane >> 5, cl = F.lane & 31, kb8 = 512 * kq + 8 * hh;
      for (int it = first + F.bid - bid0; it < last; it += stride) {
          const int l = it / (MODW / 64), e0 = (it % (MODW / 64)) * 64;
          const float* wp = P.w_ada + ((size_t)l * DM + kb8) * MODW + e0 + 32 * strip + cl; const float* cp = P.c_sample + (size_t)cl * DM + kb8;
          f32x16 acc = zero16(); float p0 = 0.f, p1 = 0.f, p2 = 0.f, p3 = 0.f;
          float wa[8], wb[8], wc[8], wd[8]; f32x4 ca[2], cb[2], cc[2], cd[2];
#define MOD_LOAD(W_, C_, s) do { _Pragma("unroll") for (int i_ = 0; i_ < 8; ++i_) W_[i_] = __builtin_nontemporal_load(wp + (size_t)((s) * 16 + i_) * MODW); \
                                 C_[0] = *(const f32x4*)(cp + (s) * 16); C_[1] = *(const f32x4*)(cp + (s) * 16 + 4); } while (0)
#define MOD_USE(W_, C_, s) do { v4u aw_, bw_; \
                                 aw_.x = cvt2(siluf(C_[0].x), siluf(C_[0].y)); aw_.y = cvt2(siluf(C_[0].z), siluf(C_[0].w)); aw_.z = cvt2(siluf(C_[1].x), siluf(C_[1].y)); aw_.w = cvt2(siluf(C_[1].z), siluf(C_[1].w)); \
                                 bw_.x = cvt2(W_[0], W_[1]); bw_.y = cvt2(W_[2], W_[3]); bw_.z = cvt2(W_[4], W_[5]); bw_.w = cvt2(W_[6], W_[7]); \
                                 acc = __builtin_amdgcn_mfma_f32_32x32x16_bf16(__builtin_bit_cast(bf16x8, aw_), __builtin_bit_cast(bf16x8, bw_), acc, 0, 0, 0); \
                                 _Pragma("unroll") for (int i_ = 0; i_ < 8; ++i_) { const f32x4 pc_ = *(const LAS f32x4*)(cpl + (kb8 + (s) * 16 + i_) * 4); \
                                     p0 += W_[i_] * pc_.x; p1 += W_[i_] * pc_.y; p2 += W_[i_] * pc_.z; p3 += W_[i_] * pc_.w; } } while (0)
          MOD_LOAD(wa, ca, 0); MOD_LOAD(wb, cb, 1); MOD_LOAD(wc, cc, 2);
#pragma unroll 1
          for (int s = 0; s < 28; s += 4) { MOD_LOAD(wd, cd, s + 3); MOD_USE(wa, ca, s); MOD_LOAD(wa, ca, s + 4); MOD_USE(wb, cb, s + 1); MOD_LOAD(wb, cb, s + 5);
              MOD_USE(wc, cc, s + 2); MOD_LOAD(wc, cc, s + 6); MOD_USE(wd, cd, s + 3); }
          MOD_LOAD(wd, cd, 31); MOD_USE(wa, ca, 28); MOD_USE(wb, cb, 29); MOD_USE(wc, cc, 30); MOD_USE(wd, cd, 31);
#undef MOD_LOAD
#undef MOD_USE
#pragma unroll
          for (int reg = 0; reg < 16; ++reg) red[(F.wave * 20 + reg) * 64 + F.lane] = acc[reg];
          red[(F.wave * 20 + 16) * 64 + F.lane] = p0; red[(F.wave * 20 + 17) * 64 + F.lane] = p1; red[(F.wave * 20 + 18) * 64 + F.lane] = p2; red[(F.wave * 20 + 19) * 64 + F.lane] = p3;
          __syncthreads();
          for (int o = F.tid; o < 2 * NMOD * 32; o += NTHR) { const int st = o / (NMOD * 32), rem = o % (NMOD * 32), row = rem >> 5, n = rem & 31; float sum = 0.f;
              if (row < NB) {
#pragma unroll
                  for (int q = 0; q < 4; ++q) sum += red[((2 * q + st) * 20 + 16 + row) * 64 + n] + red[((2 * q + st) * 20 + 16 + row) * 64 + 32 + n];
              } else { const int r = row - NB, h2 = (r >> 2) & 1, reg = (r & 3) + 4 * (r >> 3);
#pragma unroll
                  for (int q = 0; q < 4; ++q) sum += red[((2 * q + st) * 20 + reg) * 64 + 32 * h2 + n]; }
              const int col = e0 + 32 * st + n; P.MOD[((size_t)l * NMOD + row) * MODW + col] = sum + P.b_ada[l * MODW + col]; }
          __syncthreads();
      }
    }
}

constexpr int I_IN = 32 * 176, I_OUT = 32 * 64, I_G = 32 * 176, I_DN = 88 * 64, I_L = I_IN + I_OUT + 2 * I_G + I_DN;
constexpr int TR_X = 10752, TR_S2 = 8192, TR_S7 = 16384;
constexpr int MOD_P0 = 192;
static_assert(TR_S2 + TR_S7 == I_L && TR_X + TR_S2 >= I_IN + I_OUT + 2 * I_G, "conversion schedule: gate/up(l) complete before layer l's gate/up phase");
__device__ __forceinline__ TrItem tr_decode(const Ptrs& P, int l, int r) {
    TrItem t;
    if (r < I_IN) { const int kb = r / 176, nb = r % 176; t.K = DM; t.N = INW; t.src = P.w_in + (size_t)l * DM * INW + (size_t)(kb * 64) * INW + nb * 32; t.dst = wl_in(P.ws, l) + (size_t)(nb * 32) * DM + kb * 64; return t; } r -= I_IN;
    if (r < I_OUT) { const int kb = r / 64, nb = r % 64; t.K = DM; t.N = DM; t.src = P.w_out + (size_t)l * DM * DM + (size_t)(kb * 64) * DM + nb * 32; t.dst = wl_out(P.ws, l) + (size_t)(nb * 32) * DM + kb * 64; return t; } r -= I_OUT;
    if (r < 2 * I_G) { const int up = r >= I_G ? 1 : 0; r -= up * I_G; const int kb = r / 176, nb = r % 176, n0 = nb * 32; t.K = DM; t.N = DFF; t.src = (up ? P.w_up : P.w_gate) + (size_t)l * DM * DFF + (size_t)(kb * 64) * DFF + n0;
        t.dst = wl_gu(P.ws, l) + (size_t)((n0 >> 7) * 256 + up * 128 + (n0 & 127)) * DM + kb * 64; return t; } r -= 2 * I_G;
    { const int kb = r / 64, nb = r % 64; t.K = DFF; t.N = DM; t.src = P.w_down + (size_t)l * DFF * DM + (size_t)(kb * 64) * DM + nb * 32; t.dst = wl_dn(P.ws, l) + (size_t)(nb * 32) * DFF + kb * 64; return t; }
}
__device__ __forceinline__ void tr_range(const Ptrs& P, LAS float* scr, int lo, int hi, int widx, int nw, int lane) {
    float wa[32], wb[32], wc[32]; TrItem ta, tb, tc;
    int ia = lo + widx, ib = ia + nw, ic = ib + nw;
    if (ia < hi) { ta = tr_decode(P, ia / I_L, ia % I_L); tr_load(ta, wa, lane); }
    if (ib < hi) { tb = tr_decode(P, ib / I_L, ib % I_L); tr_load(tb, wb, lane); }
    while (ia < hi) {
        if (ic < hi) { tc = tr_decode(P, ic / I_L, ic % I_L); tr_load(tc, wc, lane); }
        tr_process(ta, wa, scr, lane); ia = ic + nw;
        if (ib >= hi) break;
        if (ia < hi) { ta = tr_decode(P, ia / I_L, ia % I_L); tr_load(ta, wa, lane); }
        tr_process(tb, wb, scr, lane); ib = ia + nw;
        if (ic >= hi) break;
        if (ib < hi) { tb = tr_decode(P, ib / I_L, ib % I_L); tr_load(tb, wb, lane); }
        tr_process(tc, wc, scr, lane); ic = ib + nw;
    }
}
__device__ __forceinline__ void tr_rider(const Frame& F0, int lo, int hi, int rem, int mfirst = 0, int mlast = 0) {
    Frame F = fresh(F0);
    if (hi > DEPTH * I_L) hi = DEPTH * I_L;
    if (F.bid < rem) return;
    const Ptrs P = load_ptrs();
    if (lo < hi) { tr_range(P, (LAS float*)(F.lds + RING_OFF + F.wave * 16384), lo, hi, (F.bid - rem) * NWAVES + F.wave, (F.G - rem) * NWAVES, F.lane); __syncthreads(); }
    if (mfirst < mlast) mod_items(F, P, mfirst, mlast, rem, F.G - rem);
}

__device__ __forceinline__ void p0_prologue(const Frame& F0) {
    Frame F = fresh(F0);
    const Ptrs P = load_ptrs();
    LAS float* scr = (LAS float*)(F.lds + RING_OFF + F.wave * 16384);
    const int gw = F.bid * NWAVES + F.wave, NGW = F.G * NWAVES;
    tr_range(P, scr, 0, TR_X, gw, NGW, F.lane);
    { const int gt = F.bid * NTHR + F.tid; if (gt < 1024) { float a0 = P.lower_bounds[gt], a1 = P.lower_bounds[1024 + gt], a2 = P.lower_bounds[2048 + gt], a3 = P.lower_bounds[3072 + gt];
        const float mx = fmaxf(fmaxf(a0, a1), fmaxf(a2, a3)); a0 = __expf(a0 - mx); a1 = __expf(a1 - mx); a2 = __expf(a2 - mx); a3 = __expf(a3 - mx); const float inv = 1.f / (a0 + a1 + a2 + a3);
        P.LB[gt] = 0.f; P.LB[1024 + gt] = a1 * inv; P.LB[2048 + gt] = (a1 + a2) * inv; P.LB[3072 + gt] = (a1 + a2 + a3) * inv; } }
    __syncthreads();
    { constexpr int NI = MODW / 64;
      for (int it = F.bid; it < NI + (DEPTH - 1) * MOD_P0; it += F.G) { const int gi = it < NI ? it : NI * (1 + (it - NI) / MOD_P0) + (it - NI) % MOD_P0; mod_items(F, P, gi, gi + 1, F.bid, 1, it == F.bid); } }
}

template <bool FIRST>
__device__ __forceinline__ void norm_sample_row(const Frame& F, const Ptrs& P, const float* gvec, const float* shv, const float* scv, int sr) {
    const int row = MP + sr;
    const GAS f32x4* gp = (const GAS f32x4*)gvec + F.lane; const GAS f32x4* shp = (const GAS f32x4*)shv + F.lane; const GAS f32x4* scp = (const GAS f32x4*)scv + F.lane;
    f32x4 v[8], gr[8], sq[8], Bv[8]; float s = 0.f;
#pragma unroll
    for (int j = 0; j < 8; ++j) { gr[j] = gp[64 * j]; sq[j] = scp[64 * j]; Bv[j] = shp[64 * j]; }
    if (FIRST) { const GAS f32x4* xr = (const GAS f32x4*)(P.x_sample + (size_t)sr * DM) + F.lane;
#pragma unroll
        for (int j = 0; j < 8; ++j) v[j] = xr[64 * j];
#pragma unroll
        for (int j = 0; j < 8; ++j) asm volatile("" : "+v"(v[j])); }
    else { typedef unsigned u32x2_t __attribute__((ext_vector_type(2))); const GAS u32x2_t* xr = (const GAS u32x2_t*)(P.XB + (size_t)row * DM) + F.lane; u32x2_t w[8];
#pragma unroll
        for (int j = 0; j < 8; ++j) w[j] = xr[64 * j];
#pragma unroll
        for (int j = 0; j < 8; ++j) asm volatile("" : "+v"(w[j]));
#pragma unroll
        for (int j = 0; j < 8; ++j) v[j] = (f32x4){__uint_as_float(w[j].x << 16), __uint_as_float(w[j].x & 0xffff0000u), __uint_as_float(w[j].y << 16), __uint_as_float(w[j].y & 0xffff0000u)}; }
#pragma unroll
    for (int j = 0; j < 8; ++j) asm volatile("" : "+v"(gr[j]), "+v"(sq[j]), "+v"(Bv[j]));
#pragma unroll
    for (int j = 0; j < 8; ++j) s += (v[j].x * v[j].x + v[j].y * v[j].y) + (v[j].z * v[j].z + v[j].w * v[j].w);
    const float rstd = __builtin_amdgcn_rsqf(wave_sum(s) * (1.f / DM) + EPS);
    GAS unsigned long long* o8 = (GAS unsigned long long*)(P.H + (size_t)row * DM) + F.lane;
#pragma unroll
    for (int j = 0; j < 8; ++j) { const f32x4 h = v[j] * rstd * (gr[j] * (sq[j] + 1.0f)) + Bv[j]; o8[64 * j] = (unsigned long long)pk2(h.x, h.y) | ((unsigned long long)pk2(h.z, h.w) << 32); }
}
__device__ __forceinline__ void norm_phase(const Frame& F0, int l, int which) {
    Frame F = fresh(F0);
    const Ptrs P = load_ptrs(); const float* gvec = (which ? P.norm_ffn : P.norm_mix) + l * DM; const int sh_off = which ? 3 * DM : 0, sc_off = which ? 4 * DM : DM;
    const bool first = (l == 0 && which == 0);
    for (int bi = F.bid; bi < MP / 32; bi += F.G) {
        const int blk = (4 * (bi & 7) + (bi >> 6)) * 8 + ((bi >> 3) & 7);
        const float* mod = P.MOD + ((size_t)l * NMOD + (blk >> 6)) * MODW;
        const int row0 = 32 * blk + 4 * F.wave;
        if (first) {
            f32x4 A[8], B[8];
            { const GAS f32x4* gp = (const GAS f32x4*)gvec + F.lane; const GAS f32x4* shp = (const GAS f32x4*)(mod + sh_off) + F.lane; const GAS f32x4* scp = (const GAS f32x4*)(mod + sc_off) + F.lane;
              f32x4 gr[8], sr[8];
#pragma unroll
              for (int j = 0; j < 8; ++j) { gr[j] = gp[64 * j]; sr[j] = scp[64 * j]; B[j] = shp[64 * j]; }
#pragma unroll
              for (int j = 0; j < 8; ++j) asm volatile("" : "+v"(gr[j]), "+v"(sr[j]), "+v"(B[j]));
#pragma unroll
              for (int j = 0; j < 8; ++j) A[j] = gr[j] * (sr[j] + 1.0f); }
#pragma unroll
            for (int j = 0; j < 8; ++j) asm volatile("" : "+v"(A[j]));
            f32x4 v[4][8];
#pragma unroll
            for (int r = 0; r < 4; ++r) { const GAS f32x4* xr = (const GAS f32x4*)(P.x_prompt + (size_t)(row0 + r) * DM) + F.lane;
#pragma unroll
                for (int j = 0; j < 8; ++j) v[r][j] = xr[64 * j]; }
#pragma unroll
            for (int r = 0; r < 4; ++r) { float s = 0.f;
#pragma unroll
                for (int j = 0; j < 8; ++j) s += (v[r][j].x * v[r][j].x + v[r][j].y * v[r][j].y) + (v[r][j].z * v[r][j].z + v[r][j].w * v[r][j].w);
                const float rstd = __builtin_amdgcn_rsqf(wave_sum(s) * (1.f / DM) + EPS);
                GAS unsigned long long* o8 = (GAS unsigned long long*)(P.H + (size_t)(row0 + r) * DM) + F.lane;
#pragma unroll
                for (int j = 0; j < 8; ++j) { const f32x4 h = v[r][j] * rstd * A[j] + B[j]; o8[64 * j] = (unsigned long long)pk2(h.x, h.y) | ((unsigned long long)pk2(h.z, h.w) << 32); } }
        } else {
            f32x4 A2[8], B2[8];
            { const GAS f32x4* gp = (const GAS f32x4*)gvec; const GAS f32x4* shp = (const GAS f32x4*)(mod + sh_off); const GAS f32x4* scp = (const GAS f32x4*)(mod + sc_off);
              f32x4 gr[8], sr[8];
#pragma unroll
              for (int jc = 0; jc < 4; ++jc)
#pragma unroll
                  for (int e = 0; e < 2; ++e) { const int q4 = 2 * (F.lane + 64 * jc) + e; gr[2 * jc + e] = gp[q4]; sr[2 * jc + e] = scp[q4]; B2[2 * jc + e] = shp[q4]; }
#pragma unroll
              for (int j = 0; j < 8; ++j) asm volatile("" : "+v"(gr[j]), "+v"(sr[j]), "+v"(B2[j]));
#pragma unroll
              for (int j = 0; j < 8; ++j) A2[j] = gr[j] * (sr[j] + 1.0f); }
#pragma unroll
            for (int j = 0; j < 8; ++j) asm volatile("" : "+v"(A2[j]));
            v4u vp[4][4];
#pragma unroll
            for (int r = 0; r < 4; ++r) { const GAS v4u* xr = (const GAS v4u*)(P.XB + (size_t)(row0 + r) * DM) + F.lane;
#pragma unroll
                for (int jc = 0; jc < 4; ++jc) vp[r][jc] = xr[64 * jc]; }
#pragma unroll
            for (int r = 0; r < 4; ++r) { float s = 0.f;
#pragma unroll
                for (int jc = 0; jc < 4; ++jc) { const v4u w = vp[r][jc];
                    const float x0 = __uint_as_float(w.x << 16), x1 = __uint_as_float(w.x & 0xffff0000u), x2 = __uint_as_float(w.y << 16), x3 = __uint_as_float(w.y & 0xffff0000u);
                    const float x4 = __uint_as_float(w.z << 16), x5 = __uint_as_float(w.z & 0xffff0000u), x6 = __uint_as_float(w.w << 16), x7 = __uint_as_float(w.w & 0xffff0000u);
                    s += ((x0 * x0 + x1 * x1) + (x2 * x2 + x3 * x3)) + ((x4 * x4 + x5 * x5) + (x6 * x6 + x7 * x7)); }
                const float rstd = __builtin_amdgcn_rsqf(wave_sum(s) * (1.f / DM) + EPS);
                GAS v4u* o16 = (GAS v4u*)(P.H + (size_t)(row0 + r) * DM) + F.lane;
#pragma unroll
                for (int jc = 0; jc < 4; ++jc) { const v4u w = vp[r][jc];
                    const f32x4 xa = (f32x4){__uint_as_float(w.x << 16), __uint_as_float(w.x & 0xffff0000u), __uint_as_float(w.y << 16), __uint_as_float(w.y & 0xffff0000u)};
                    const f32x4 xb = (f32x4){__uint_as_float(w.z << 16), __uint_as_float(w.z & 0xffff0000u), __uint_as_float(w.w << 16), __uint_as_float(w.w & 0xffff0000u)};
                    const f32x4 ha = xa * rstd * A2[2 * jc] + B2[2 * jc], hb = xb * rstd * A2[2 * jc + 1] + B2[2 * jc + 1];
                    v4u o; o.x = pk2(ha.x, ha.y); o.y = pk2(ha.z, ha.w); o.z = pk2(hb.x, hb.y); o.w = pk2(hb.z, hb.w); o16[64 * jc] = o; } }
        }
    }
    if (first) { for (int sr = F.bid; sr < MS; sr += F.G) if (F.wave == 0) norm_sample_row<true>(F, P, gvec, P.MOD + ((size_t)l * NMOD + NB + sr) * MODW + sh_off, P.MOD + ((size_t)l * NMOD + NB + sr) * MODW + sc_off, sr); }
    else       { for (int sr = F.bid; sr < MS; sr += F.G) if (F.wave == 0) norm_sample_row<false>(F, P, gvec, P.MOD + ((size_t)l * NMOD + NB + sr) * MODW + sh_off, P.MOD + ((size_t)l * NMOD + NB + sr) * MODW + sc_off, sr); }
}

__device__ __forceinline__ void prep_phase(const Frame& F0, int l) {
    Frame F = fresh(F0);
    const Ptrs P = load_ptrs();
    const int gw = F.bid * NWAVES + F.wave, NGW = F.G * NWAVES;
    typedef float f32x2v __attribute__((ext_vector_type(2)));
    const f32x2v kn = *(const f32x2v*)(P.k_norm + l * HD + 2 * F.lane);
    for (int it = gw; it < MS * 2; it += NGW) {
        const int row = MP + (it >> 1), kvh = it & 1;
        const float* pr = P.PROJ + (size_t)row * INW + kvh * HD + 2 * F.lane;
        const f32x2v k = *(const f32x2v*)(pr + C_KA), v = *(const f32x2v*)(pr + C_VA);
        const float rstd = __builtin_amdgcn_rsqf(wave_sum(k.x * k.x + k.y * k.y) * (1.f / HD) + EPS);
        const f32x2v ko = k * rstd * kn;
        *(f32x2v*)(P.KN + (size_t)row * 256 + kvh * HD + 2 * F.lane) = ko;
        if (row < MP) { const int b = row >> 11, t = row & 2047;
            if (t >= SEQ - WIN) { const size_t off = ((((size_t)l * NB + b) * WIN + (t - (SEQ - WIN))) * 2 + kvh) * HD + 2 * F.lane; *(f32x2v*)(P.out + O_KP + off) = ko; *(f32x2v*)(P.out + O_VP + off) = v; } }
        else { const int b = row - MP; const size_t off = ((((size_t)l * DB + b) * WIN + (WIN - 1)) * 2 + kvh) * HD + 2 * F.lane; *(f32x2v*)(P.out + O_KS + off) = ko; *(f32x2v*)(P.out + O_VS + off) = v; }
    }
}
__device__ __forceinline__ void cache_shift(const Frame& F0, int l) {
    Frame F = fresh(F0);
    const Ptrs P = load_ptrs();
    { const int gt = F.bid * NTHR + F.tid, NGT = F.G * NTHR; constexpr int per_b = (WIN - 1) * 64;
      for (int i = gt; i < DB * per_b; i += NGT) { const int b = i / per_b, rem = i % per_b, w = rem >> 6, c4 = rem & 63;
          const size_t src = (((size_t)l * DB + b) * WIN + w + 1) * 256 + c4 * 4, dst = (((size_t)l * DB + b) * WIN + w) * 256 + c4 * 4;
          __builtin_nontemporal_store(*(const f32x4*)(P.cache_k + src), (f32x4*)(P.out + O_KS + dst)); __builtin_nontemporal_store(*(const f32x4*)(P.cache_v + src), (f32x4*)(P.out + O_VS + dst)); } }
}

__device__ __forceinline__ void hgrn_unit(const Frame& F, const Ptrs& P, int l, int u) {
    const int us = u - 32, b = us >> 3, h = us & 7, row = MP + b;
    const float* s0 = P.state + (((size_t)l * DB + b) * NLH + h) * (HD * HD); float* sout = P.out + O_SS + (((size_t)l * DB + b) * NLH + h) * (HD * HD);
    const int v4 = F.tid & 31, kg = F.tid >> 5;
    LAS float* Fs = (LAS float*)(F.lds + RING_OFF); LAS float* Ks = Fs + 128; LAS float* Qs = Ks + 128; LAS float* Vs = Qs + 128; LAS float* Gs = Vs + 128; LAS float* Os = Gs + 128; LAS float* Rd = Os + 128;
    f32x4 S[8];
#pragma unroll
    for (int j = 0; j < 8; ++j) S[j] = __builtin_nontemporal_load((const f32x4*)(s0 + (size_t)(kg * 8 + j) * HD + 4 * v4));
    const float gn0 = P.g_norm[l * HD + F.lane], gn1 = P.g_norm[l * HD + 64 + F.lane];
    if (F.tid < HD) { const int k = F.tid; const float* pr = P.PROJ + (size_t)row * INW + h * HD + k;
        const float q = pr[C_QL], vv = pr[C_IL], g = pr[C_GL], lb = P.LB[l * 1024 + h * HD + k]; const float f = fmaxf(pr[C_FL], -80.f);
        const float ex = __expf(-f), sg = __builtin_amdgcn_rcpf(1.0f + ex);
        Fs[k] = lb + (1.0f - lb) * sg; Ks[k] = (1.0f - lb) * (ex * sg); Qs[k] = siluf(q); Vs[k] = vv; Gs[k] = siluf(g); }
    __syncthreads();
    { const f32x4 vt = *(const LAS f32x4*)(Vs + 4 * v4); f32x4 o = (f32x4){0.f, 0.f, 0.f, 0.f};
#pragma unroll
      for (int j = 0; j < 8; ++j) { const int k = kg * 8 + j; S[j] = S[j] * Fs[k] + vt * Ks[k]; o += S[j] * Qs[k]; }
#pragma unroll
      for (int c = 0; c < 4; ++c) o[c] += __shfl_xor(o[c], 32);
      if (F.lane < 32) *(LAS f32x4*)(Rd + F.wave * HD + 4 * v4) = o; }
#pragma unroll
    for (int j = 0; j < 8; ++j) __builtin_nontemporal_store(S[j], (f32x4*)(sout + (size_t)(kg * 8 + j) * HD + 4 * v4));
    __syncthreads();
    if (F.wave == 0) { float o0 = 0.f, o1 = 0.f;
#pragma unroll
        for (int w = 0; w < 8; ++w) { o0 += Rd[w * HD + F.lane]; o1 += Rd[w * HD + 64 + F.lane]; }
        const float rstd = __builtin_amdgcn_rsqf(wave_sum(o0 * o0 + o1 * o1) * (1.f / HD) + EPS);
        bf16* mp = P.MIX + (size_t)row * DM + h * HD;
        mp[F.lane] = (bf16)f2bf(o0 * rstd * gn0 * Gs[F.lane]); mp[64 + F.lane] = (bf16)f2bf(o1 * rstd * gn1 * Gs[64 + F.lane]); }
    __syncthreads();
}

__device__ __forceinline__ void attn_item(Frame& F, const Ptrs& P, int l, int item) {
    const int p = item * 128 + (F.tid >> 2), dq = F.tid & 3;
    if (p >= MP * NAH + MS * NAH) return;
    const bool prompt = p < MP * NAH; int b, hq, t, row, nkeys;
    if (prompt) { b = p >> 14; hq = (p >> 11) & 7; t = p & 2047; row = b * SEQ + t; nkeys = (t < WIN ? t : WIN) + 1; }
    else { const int ps = p - MP * NAH; b = ps >> 3; hq = ps & 7; t = 0; row = MP + b; nkeys = WIN + 1; }
    const int kvh = hq >> 2;
    float q[32], acc[32];
    { const float* qp = P.PROJ + (size_t)row * INW + C_QA + hq * HD + dq * 32; float ss = 0.f;
#pragma unroll
      for (int j = 0; j < 32; j += 4) { const f32x4 x = *(const f32x4*)(qp + j); q[j] = x.x; q[j + 1] = x.y; q[j + 2] = x.z; q[j + 3] = x.w; ss += (x.x * x.x + x.y * x.y) + (x.z * x.z + x.w * x.w); }
      ss += __shfl_xor(ss, 1); ss += __shfl_xor(ss, 2);
      const float rstd = __builtin_amdgcn_rsqf(ss * (1.f / HD) + EPS) * ATT_SCALE; const float* qn = P.q_norm + l * HD + dq * 32;
#pragma unroll
      for (int j = 0; j < 32; ++j) { q[j] *= rstd * qn[j]; acc[j] = 0.f; } }
    const float slope = exp2f(-(float)(hq + 1));
    float m = P.sinks[l * NAH + hq], den = 1.0f;
    for (int jj = 0; jj < nkeys; ++jj) {
        const float* kp; const float* vp; float dist;
        if (prompt) { const int krow = row - (nkeys - 1) + jj; kp = P.KN + (size_t)krow * 256 + kvh * HD + dq * 32; vp = P.PROJ + (size_t)krow * INW + C_VA + kvh * HD + dq * 32; dist = (float)(nkeys - 1 - jj); }
        else { dist = (float)(WIN - jj);
            if (jj < WIN) { const size_t off = ((((size_t)l * DB + b) * WIN + jj) * 2 + kvh) * HD + dq * 32; kp = P.cache_k + off; vp = P.cache_v + off; }
            else { kp = P.KN + (size_t)row * 256 + kvh * HD + dq * 32; vp = P.PROJ + (size_t)row * INW + C_VA + kvh * HD + dq * 32; } }
        float s = 0.f;
#pragma unroll
        for (int j = 0; j < 32; j += 4) { const f32x4 x = *(const f32x4*)(kp + j); s += (q[j] * x.x + q[j + 1] * x.y) + (q[j + 2] * x.z + q[j + 3] * x.w); }
        s += __shfl_xor(s, 1); s += __shfl_xor(s, 2);
        s -= slope * dist;
        const float mn = fmaxf(m, s), corr = __expf(m - mn), pp = __expf(s - mn);
        den = den * corr + pp; m = mn;
#pragma unroll
        for (int j = 0; j < 32; j += 4) { const f32x4 x = *(const f32x4*)(vp + j); acc[j] = acc[j] * corr + pp * x.x; acc[j + 1] = acc[j + 1] * corr + pp * x.y; acc[j + 2] = acc[j + 2] * corr + pp * x.z; acc[j + 3] = acc[j + 3] * corr + pp * x.w; }
    }
    const float inv = 1.0f / den;
    bf16* mp = P.MIX + (size_t)row * DM + 1024 + hq * HD + dq * 32;
#pragma unroll
    for (int j = 0; j < 32; j += 8) { v4u o; o.x = pk2(acc[j] * inv, acc[j + 1] * inv); o.y = pk2(acc[j + 2] * inv, acc[j + 3] * inv); o.z = pk2(acc[j + 4] * inv, acc[j + 5] * inv); o.w = pk2(acc[j + 6] * inv, acc[j + 7] * inv); *(v4u*)(mp + j) = o; }
}

__device__ __forceinline__ bf16 cvt1(float x) { return (bf16)(cvt2(x, 0.f) & 0xffffu); }
__device__ __forceinline__ int crow(int reg, int h) { return (reg & 3) + 8 * (reg >> 2) + 4 * h; }
template <int NK>
__device__ __forceinline__ void mma_tile(f32x16& acc, const LAS bf16* X, int sx, const LAS bf16* Y, int sy, int lane) {
    const int r = lane & 31, h = lane >> 5;
    const LAS bf16* xp = X + r * sx + 8 * h; const LAS bf16* yp = Y + r * sy + 8 * h;
    bf16x8 a[NK], b[NK];
#pragma unroll
    for (int ks = 0; ks < NK; ++ks) { a[ks] = *(const LAS bf16x8*)(xp + ks * 16); b[ks] = *(const LAS bf16x8*)(yp + ks * 16); }
    asm volatile("" ::: "memory");
#pragma unroll
    for (int ks = 0; ks < NK; ++ks) acc = __builtin_amdgcn_mfma_f32_32x32x16_bf16(a[ks], b[ks], acc, 0, 0, 0);
}
__device__ __forceinline__ void mma_tile_n(f32x16& acc, const LAS bf16* X, int sx, const LAS bf16* Y, int sy, int nk, int lane) {
    const int r = lane & 31, h = lane >> 5;
    const LAS bf16* xp = X + r * sx + 8 * h; const LAS bf16* yp = Y + r * sy + 8 * h;
    for (int ks = 0; ks < nk; ++ks) { const bf16x8 a = *(const LAS bf16x8*)(xp + ks * 16), b = *(const LAS bf16x8*)(yp + ks * 16);
        acc = __builtin_amdgcn_mfma_f32_32x32x16_bf16(a, b, acc, 0, 0, 0); }
}

constexpr int HG_QT = 0, HG_KT = 17408, HG_KTT = 34816, HG_VT = 53248, HG_AM = 71680, HG_ST = 80896, HG_TOT = 115712, HG_VEC = 119808, HG_OB = HG_KT;
constexpr int SQ = 136, SK = 72, SO = 132;
template <bool FULL, int SKIP = 0>
__device__ __forceinline__ void hgrn_seg(const Frame& F, const Ptrs& P, int l, int unit) {
    const int b = unit >> 6, h = (unit >> 3) & 7, seg = unit & 7, row0 = b * SEQ + seg * 256;
    const int tid = F.tid, lane = F.lane, wave = F.wave, kch = tid & 127, tg = tid >> 7, hh = lane >> 5, cl = lane & 31;
    LAS unsigned char* L = F.lds + RING_OFF;
    LAS bf16* QT = (LAS bf16*)(L + HG_QT); LAS bf16* KT = (LAS bf16*)(L + HG_KT); LAS bf16* KTt = (LAS bf16*)(L + HG_KTT); LAS bf16* Vt = (LAS bf16*)(L + HG_VT);
    LAS bf16* Am = (LAS bf16*)(L + HG_AM); LAS bf16* St = (LAS bf16*)(L + HG_ST); LAS float* tot = (LAS float*)(L + HG_TOT);
    LAS float* er = (LAS float*)(L + HG_VEC); LAS float* e63 = er + 128; LAS float* e63r = er + 256; LAS float* Ob = (LAS float*)(L + HG_OB);
    float* U = (float*)(P.ws + WS_U); float* Dg = (float*)(P.ws + WS_DG);
    const int kb0 = (2 * wave) >> 2, vb0 = (2 * wave) & 3, kb1 = (2 * wave + 1) >> 2, vb1 = (2 * wave + 1) & 3;
    f32x16 S0 = zero16(), S1 = zero16();
    if (FULL && !(SKIP & 1)) {
        LAS float* Wl = (LAS float*)(L + HG_ST);
        const v4u* Ub = (const v4u*)U + ((size_t)(unit - seg) * 8 + wave) * 256 + lane;
        v4u uu[7][4];
#pragma unroll
        for (int j = 0; j < 7; ++j) { uu[j][0] = uu[j][1] = uu[j][2] = uu[j][3] = (v4u){0u, 0u, 0u, 0u};
            if (j < seg) { const v4u* uj = Ub + (size_t)j * 2048; uu[j][0] = uj[0]; uu[j][1] = uj[64]; uu[j][2] = uj[128]; uu[j][3] = uj[192]; } }
        if (tg == 0) { float dgv[7];
#pragma unroll
            for (int j = 0; j < 7; ++j) { dgv[j] = 1.f; if (j < seg) dgv[j] = Dg[(size_t)(unit - seg + j) * HD + kch]; }
#pragma unroll
            for (int j = 0; j < 7; ++j) asm volatile("" : "+v"(dgv[j]));
            float w = 1.f;
#pragma unroll
            for (int j = 6; j >= 0; --j) if (j < seg) { Wl[j * HD + kch] = w; w *= dgv[j]; } }
        __syncthreads();
#pragma unroll
        for (int j = 0; j < 7; ++j) asm volatile("" : "+v"(uu[j][0]), "+v"(uu[j][1]), "+v"(uu[j][2]), "+v"(uu[j][3]));
#pragma unroll
        for (int j = 0; j < 7; ++j) if (j < seg) { const LAS float* wj = Wl + j * HD;
#pragma unroll
            for (int g = 0; g < 4; ++g) { const f32x4 d0 = *(const LAS f32x4*)(wj + 32 * kb0 + 8 * g + 4 * hh), d1 = *(const LAS f32x4*)(wj + 32 * kb1 + 8 * g + 4 * hh);
                const unsigned a0 = (g & 1) ? uu[j][g >> 1].z : uu[j][g >> 1].x, a1 = (g & 1) ? uu[j][g >> 1].w : uu[j][g >> 1].y, b0 = (g & 1) ? uu[j][2 + (g >> 1)].z : uu[j][2 + (g >> 1)].x, b1 = (g & 1) ? uu[j][2 + (g >> 1)].w : uu[j][2 + (g >> 1)].y;
                S0[4 * g] += d0.x * __uint_as_float(a0 << 16); S0[4 * g + 1] += d0.y * __uint_as_float(a0 & 0xffff0000u); S0[4 * g + 2] += d0.z * __uint_as_float(a1 << 16); S0[4 * g + 3] += d0.w * __uint_as_float(a1 & 0xffff0000u);
                S1[4 * g] += d1.x * __uint_as_float(b0 << 16); S1[4 * g + 1] += d1.y * __uint_as_float(b0 & 0xffff0000u); S1[4 * g + 2] += d1.z * __uint_as_float(b1 << 16); S1[4 * g + 3] += d1.w * __uint_as_float(b1 & 0xffff0000u); } }
        __syncthreads();
    }
    typedef float f32x2v __attribute__((ext_vector_type(2)));
    const f32x2v lb2 = *(const f32x2v*)(P.LB + l * 1024 + h * HD + 2 * lane);
    const f32x2v gn2 = *(const f32x2v*)(P.g_norm + l * HD + 2 * lane);
    float Bseg0 = 0.f, Bseg1 = 0.f;
    const size_t hb = ((size_t)h * MPAD + row0 + 8 * wave) * HD + 2 * lane;
    const float* fbase = (const float*)(P.ws + WS_FR) + hb; const bf16* qbase = (const bf16*)(P.ws + WS_QL) + hb; const bf16* vbase = (const bf16*)(P.ws + WS_VL) + hb;
    const bf16* gbase = (const bf16*)(P.ws + WS_GL) + ((size_t)h * MPAD + row0) * HD + 2 * lane;
    f32x2v fv[8]; unsigned qv[8], vv[8];
#pragma unroll
    for (int i = 0; i < 8; ++i) { fv[i] = *(const f32x2v*)(fbase + i * HD); vv[i] = *(const unsigned*)(vbase + i * HD); if (FULL) qv[i] = *(const unsigned*)(qbase + i * HD); }
    for (int c = 0; c < 4; ++c) {
        unsigned gq[8];
        if (FULL) {
#pragma unroll
            for (int tt = 0; tt < 8; ++tt) gq[tt] = *(const unsigned*)(gbase + (size_t)(64 * c + 8 * wave + tt) * HD); }
        float pre0[8], pre1[8], kk0[8], kk1[8]; float run0 = 0.f, run1 = 0.f;
        if (SKIP & 16) {
#pragma unroll
            for (int i = 0; i < 8; ++i) { pre0[i] = pre1[i] = -0.1f * i; kk0[i] = kk1[i] = 0.5f; } run0 = run1 = -0.7f; } else
#pragma unroll
        for (int i = 0; i < 8; ++i) {
            { const float fr = fmaxf(fv[i].x, -80.f); const float ex = __expf(-fr), sg = __builtin_amdgcn_rcpf(1.0f + ex); run0 += __log2f(lb2.x + (1.0f - lb2.x) * sg); pre0[i] = run0; kk0[i] = (1.0f - lb2.x) * (ex * sg); }
            { const float fr = fmaxf(fv[i].y, -80.f); const float ex = __expf(-fr), sg = __builtin_amdgcn_rcpf(1.0f + ex); run1 += __log2f(lb2.y + (1.0f - lb2.y) * sg); pre1[i] = run1; kk1[i] = (1.0f - lb2.y) * (ex * sg); } }
        *(LAS f32x2v*)(tot + wave * 128 + 2 * lane) = (f32x2v){run0, run1};
        __syncthreads();
        float off0 = 0.f, off1 = 0.f, r0 = 0.f, r1 = 0.f, b630 = 0.f, b631 = 0.f;
#pragma unroll
        for (int g = 0; g < 8; ++g) { const f32x2v tv = *(const LAS f32x2v*)(tot + g * 128 + 2 * lane); if (g < wave) { off0 += tv.x; off1 += tv.y; } if (g < 4) { r0 += tv.x; r1 += tv.y; } b630 += tv.x; b631 += tv.y; }
        unsigned kpk0[4], kpk1[4], vpk0[4], vpk1[4];
        if (SKIP & 16) {
#pragma unroll
            for (int i = 0; i < 4; ++i) { kpk0[i] = kpk1[i] = 0x3f003f00u; vpk0[i] = vv[2 * i]; vpk1[i] = vv[2 * i + 1]; } } else
#pragma unroll
        for (int i = 0; i < 8; i += 2) {
            const float bt00 = off0 + pre0[i], bt01 = off1 + pre1[i], bt10 = off0 + pre0[i + 1], bt11 = off1 + pre1[i + 1];
            const float k00 = kk0[i] * __builtin_amdgcn_exp2f(fminf(r0 - bt00, 115.f)), k01 = kk1[i] * __builtin_amdgcn_exp2f(fminf(r1 - bt01, 115.f)), k10 = kk0[i + 1] * __builtin_amdgcn_exp2f(fminf(r0 - bt10, 115.f)), k11 = kk1[i + 1] * __builtin_amdgcn_exp2f(fminf(r1 - bt11, 115.f));
            kpk0[i >> 1] = cvt2(k00, k10); kpk1[i >> 1] = cvt2(k01, k11);
            vpk0[i >> 1] = (vv[i] & 0xffffu) | (vv[i + 1] << 16); vpk1[i >> 1] = (vv[i] >> 16) | (vv[i + 1] & 0xffff0000u);
            if (FULL) {
                const float q00 = __uint_as_float(qv[i] << 16) * __builtin_amdgcn_exp2f(fminf(bt00 - r0, 115.f)), q01 = __uint_as_float(qv[i] & 0xffff0000u) * __builtin_amdgcn_exp2f(fminf(bt01 - r1, 115.f));
                const float q10 = __uint_as_float(qv[i + 1] << 16) * __builtin_amdgcn_exp2f(fminf(bt10 - r0, 115.f)), q11 = __uint_as_float(qv[i + 1] & 0xffff0000u) * __builtin_amdgcn_exp2f(fminf(bt11 - r1, 115.f));
                *(LAS unsigned*)(QT + (8 * wave + i) * SQ + 2 * lane) = cvt2(q00, q01); *(LAS unsigned*)(QT + (8 * wave + i + 1) * SQ + 2 * lane) = cvt2(q10, q11);
                *(LAS unsigned*)(KT + (8 * wave + i) * SQ + 2 * lane) = cvt2(k00, k01); *(LAS unsigned*)(KT + (8 * wave + i + 1) * SQ + 2 * lane) = cvt2(k10, k11); }
        }
        { v4u w; w.x = kpk0[0]; w.y = kpk0[1]; w.z = kpk0[2]; w.w = kpk0[3]; *(LAS v4u*)(KTt + (2 * lane) * SK + 8 * wave) = w;
          w.x = kpk1[0]; w.y = kpk1[1]; w.z = kpk1[2]; w.w = kpk1[3]; *(LAS v4u*)(KTt + (2 * lane + 1) * SK + 8 * wave) = w;
          w.x = vpk0[0]; w.y = vpk0[1]; w.z = vpk0[2]; w.w = vpk0[3]; *(LAS v4u*)(Vt + (2 * lane) * SK + 8 * wave) = w;
          w.x = vpk1[0]; w.y = vpk1[1]; w.z = vpk1[2]; w.w = vpk1[3]; *(LAS v4u*)(Vt + (2 * lane + 1) * SK + 8 * wave) = w; }
        if (wave == 0) { *(LAS f32x2v*)(er + 2 * lane) = (f32x2v){__builtin_amdgcn_exp2f(r0), __builtin_amdgcn_exp2f(r1)}; *(LAS f32x2v*)(e63 + 2 * lane) = (f32x2v){__builtin_amdgcn_exp2f(b630), __builtin_amdgcn_exp2f(b631)}; *(LAS f32x2v*)(e63r + 2 * lane) = (f32x2v){__builtin_amdgcn_exp2f(b630 - r0), __builtin_amdgcn_exp2f(b631 - r1)}; }
        Bseg0 += b630; Bseg1 += b631;
        if (c < 3) {
#pragma unroll
            for (int i = 0; i < 8; ++i) { fv[i] = *(const f32x2v*)(fbase + (64 * (c + 1) + i) * HD); vv[i] = *(const unsigned*)(vbase + (64 * (c + 1) + i) * HD); if (FULL) qv[i] = *(const unsigned*)(qbase + (64 * (c + 1) + i) * HD); } }
        __syncthreads();
        if (!(SKIP & 8)) {
        if (FULL) {
            typedef unsigned u32x2_t __attribute__((ext_vector_type(2)));
            f32x4 ev0[4], ev1[4];
#pragma unroll
            for (int j = 0; j < 4; ++j) { ev0[j] = *(const LAS f32x4*)(er + 32 * kb0 + 8 * j + 4 * hh); ev1[j] = *(const LAS f32x4*)(er + 32 * kb1 + 8 * j + 4 * hh); }
#pragma unroll
            for (int j = 0; j < 4; ++j) {
                { u32x2_t w; w.x = cvt2(S0[4 * j] * ev0[j].x, S0[4 * j + 1] * ev0[j].y); w.y = cvt2(S0[4 * j + 2] * ev0[j].z, S0[4 * j + 3] * ev0[j].w); *(LAS u32x2_t*)(St + (32 * vb0 + cl) * SQ + 32 * kb0 + 8 * j + 4 * hh) = w; }
                { u32x2_t w; w.x = cvt2(S1[4 * j] * ev1[j].x, S1[4 * j + 1] * ev1[j].y); w.y = cvt2(S1[4 * j + 2] * ev1[j].z, S1[4 * j + 3] * ev1[j].w); *(LAS u32x2_t*)(St + (32 * vb1 + cl) * SQ + 32 * kb1 + 8 * j + 4 * hh) = w; }
            }
            if (wave < 3) { const int tb = wave > 0 ? 1 : 0, sb = wave > 1 ? 1 : 0; f32x16 a = zero16();
                mma_tile<8>(a, QT + 32 * tb * SQ, SQ, KT + 32 * sb * SQ, SQ, lane);
#pragma unroll
                for (int reg = 0; reg < 16; ++reg) { const int t = 32 * tb + crow(reg, hh), s = 32 * sb + cl; Am[t * SK + s] = cvt1(s <= t ? a[reg] : 0.f); } }
        }
        { f32x16 p0 = zero16(), p1 = zero16();
          mma_tile<4>(p0, KTt + 32 * kb0 * SK, SK, Vt + 32 * vb0 * SK, SK, lane); mma_tile<4>(p1, KTt + 32 * kb1 * SK, SK, Vt + 32 * vb1 * SK, SK, lane);
#pragma unroll
          for (int j = 0; j < 4; ++j) {
              { const f32x4 a = *(const LAS f32x4*)(e63 + 32 * kb0 + 8 * j + 4 * hh), bq = *(const LAS f32x4*)(e63r + 32 * kb0 + 8 * j + 4 * hh);
                S0[4 * j] = a.x * S0[4 * j] + bq.x * p0[4 * j]; S0[4 * j + 1] = a.y * S0[4 * j + 1] + bq.y * p0[4 * j + 1]; S0[4 * j + 2] = a.z * S0[4 * j + 2] + bq.z * p0[4 * j + 2]; S0[4 * j + 3] = a.w * S0[4 * j + 3] + bq.w * p0[4 * j + 3]; }
              { const f32x4 a = *(const LAS f32x4*)(e63 + 32 * kb1 + 8 * j + 4 * hh), bq = *(const LAS f32x4*)(e63r + 32 * kb1 + 8 * j + 4 * hh);
                S1[4 * j] = a.x * S1[4 * j] + bq.x * p1[4 * j]; S1[4 * j + 1] = a.y * S1[4 * j + 1] + bq.y * p1[4 * j + 1]; S1[4 * j + 2] = a.z * S1[4 * j + 2] + bq.z * p1[4 * j + 2]; S1[4 * j + 3] = a.w * S1[4 * j + 3] + bq.w * p1[4 * j + 3]; }
          } }
        }
        __syncthreads();
        if (FULL) {
            if (!(SKIP & 4)) { const int tb = wave >> 2, vb = wave & 3; f32x16 o = zero16();
              if (tb == 0) mma_tile<2>(o, Am, SK, Vt + 32 * vb * SK, SK, lane); else mma_tile<4>(o, Am + 32 * SK, SK, Vt + 32 * vb * SK, SK, lane);
              mma_tile<8>(o, QT + 32 * tb * SQ, SQ, St + 32 * vb * SQ, SQ, lane);
#pragma unroll
              for (int reg = 0; reg < 16; ++reg) Ob[(32 * tb + crow(reg, hh)) * SO + 32 * vb + cl] = o[reg]; }
            __syncthreads();
            if (!(SKIP & 2))
#pragma unroll
            for (int tt = 0; tt < 8; ++tt) { const int t = 8 * wave + tt; const f32x2v o = *(const LAS f32x2v*)(Ob + t * SO + 2 * lane);
                const float rstd = __builtin_amdgcn_rsqf(wave_sum(o.x * o.x + o.y * o.y) * (1.f / HD) + EPS);
                *(unsigned*)(P.MIX + (size_t)(row0 + 64 * c + t) * DM + h * HD + 2 * lane) = cvt2(o.x * rstd * gn2.x * __uint_as_float(gq[tt] << 16), o.y * rstd * gn2.y * __uint_as_float(gq[tt] & 0xffff0000u)); }
        }
    }
    if (!FULL) {
        v4u* Uu = (v4u*)U + ((size_t)unit * 8 + wave) * 256 + lane;
#pragma unroll
        for (int q = 0; q < 2; ++q) { v4u w0, w1;
            w0.x = cvt2(S0[8 * q], S0[8 * q + 1]); w0.y = cvt2(S0[8 * q + 2], S0[8 * q + 3]); w0.z = cvt2(S0[8 * q + 4], S0[8 * q + 5]); w0.w = cvt2(S0[8 * q + 6], S0[8 * q + 7]);
            w1.x = cvt2(S1[8 * q], S1[8 * q + 1]); w1.y = cvt2(S1[8 * q + 2], S1[8 * q + 3]); w1.z = cvt2(S1[8 * q + 4], S1[8 * q + 5]); w1.w = cvt2(S1[8 * q + 6], S1[8 * q + 7]);
            Uu[64 * q] = w0; Uu[128 + 64 * q] = w1; }
        if (wave == 0) *(f32x2v*)(Dg + (size_t)unit * HD + 2 * lane) = (f32x2v){__builtin_amdgcn_exp2f(Bseg0), __builtin_amdgcn_exp2f(Bseg1)};
    } else if (seg == 7) {
        float* so0 = P.out + O_SP + (((size_t)l * NB + b) * NLH + h) * (HD * HD) + (32 * kb0 + 4 * hh) * HD + 32 * vb0 + cl;
        float* so1 = P.out + O_SP + (((size_t)l * NB + b) * NLH + h) * (HD * HD) + (32 * kb1 + 4 * hh) * HD + 32 * vb1 + cl;
#pragma unroll
        for (int g = 0; g < 4; ++g) {
            __builtin_nontemporal_store(S0[4 * g], so0); __builtin_nontemporal_store(S0[4 * g + 1], so0 + HD); __builtin_nontemporal_store(S0[4 * g + 2], so0 + 2 * HD); __builtin_nontemporal_store(S0[4 * g + 3], so0 + 3 * HD);
            __builtin_nontemporal_store(S1[4 * g], so1); __builtin_nontemporal_store(S1[4 * g + 1], so1 + HD); __builtin_nontemporal_store(S1[4 * g + 2], so1 + 2 * HD); __builtin_nontemporal_store(S1[4 * g + 3], so1 + 3 * HD);
            so0 += 8 * HD; so1 += 8 * HD; asm volatile("" : "+v"(so0), "+v"(so1) :: "memory"); }
    }
    __syncthreads();
}

constexpr int AT_KB = 0, AT_VR = 52224, SVR = 160;
__device__ __forceinline__ void attn_unit(const Frame& F, const Ptrs& P, int l, int unit) {
    const int b = unit >> 6, qblk = (unit >> 1) & 31, kvh = unit & 1;
    const int tid = F.tid, lane = F.lane, wave = F.wave, hh = lane >> 5, cl = lane & 31;
    const int q0 = 64 * qblk, nprev = q0 < WIN ? q0 : WIN, nk = nprev + 64, k0 = q0 - nprev, rowb = b * SEQ;
    LAS unsigned char* L = F.lds + RING_OFF;
    LAS bf16* Kb = (LAS bf16*)(L + AT_KB); LAS bf16* Vr = (LAS bf16*)(L + AT_VR);
    const bf16* QA = (const bf16*)(P.ws + WS_QA); const bf16* KA = (const bf16*)(P.ws + WS_KA); const bf16* VA = (const bf16*)(P.ws + WS_VA);
    const int sub = wave >> 2, hq = kvh * 4 + (wave & 3);
    typedef unsigned u32x2_t __attribute__((ext_vector_type(2)));
    bf16x8 qf[8];
    { const bf16* qp = QA + (size_t)(rowb + q0 + 32 * sub + cl) * 1024 + hq * HD + 8 * hh;
#pragma unroll
      for (int ks = 0; ks < 8; ++ks) qf[ks] = *(const bf16x8*)(qp + 16 * ks); }
    bf16x8 kx[6]; v4u vx[6];
#pragma unroll
    for (int i = 0; i < 6; ++i) { const int idx = tid + NTHR * i; int key = idx >> 4; key = key < nk ? key : nk - 1; const int d8 = (idx & 15) * 8;
        kx[i] = *(const bf16x8*)(KA + (size_t)(rowb + k0 + key) * 256 + kvh * HD + d8); }
#pragma unroll
    for (int i = 0; i < 6; ++i) { const int idx = tid + NTHR * i; int key = idx >> 4; key = key < nk ? key : nk - 1; const int d8 = (idx & 15) * 8;
        vx[i] = *(const v4u*)(VA + (size_t)(rowb + k0 + key) * 256 + kvh * HD + d8); }
    const f32x4 kn0 = *(const f32x4*)(P.k_norm + l * HD + (tid & 15) * 8), kn1 = *(const f32x4*)(P.k_norm + l * HD + (tid & 15) * 8 + 4);
#pragma unroll
    for (int i = 0; i < 6; ++i) { const int idx = tid + NTHR * i, key = idx >> 4, d8 = (idx & 15) * 8;
        float xf[8], ss = 0.f;
#pragma unroll
        for (int j = 0; j < 8; ++j) { xf[j] = __uint_as_float((unsigned)(unsigned short)kx[i][j] << 16); ss += xf[j] * xf[j]; }
        ss = row16_sum(ss);
        const float rs = __builtin_amdgcn_rsqf(ss * (1.f / HD) + EPS);
        xf[0] *= rs * kn0.x; xf[1] *= rs * kn0.y; xf[2] *= rs * kn0.z; xf[3] *= rs * kn0.w; xf[4] *= rs * kn1.x; xf[5] *= rs * kn1.y; xf[6] *= rs * kn1.z; xf[7] *= rs * kn1.w;
        if (key < nk) { v4u w; w.x = cvt2(xf[0], xf[1]); w.y = cvt2(xf[2], xf[3]); w.z = cvt2(xf[4], xf[5]); w.w = cvt2(xf[6], xf[7]); *(LAS v4u*)(Kb + key * SQ + d8) = w;
            if (qblk >= 30 && key >= nprev) { float* op = P.out + O_KP + ((((size_t)l * NB + b) * WIN + (q0 + key - nprev - (SEQ - WIN))) * 2 + kvh) * HD + d8;
                *(f32x4*)op = (f32x4){xf[0], xf[1], xf[2], xf[3]}; *(f32x4*)(op + 4) = (f32x4){xf[4], xf[5], xf[6], xf[7]}; } } }
#pragma unroll
    for (int i = 0; i < 6; ++i) { const int idx = tid + NTHR * i, key = idx >> 4, d8 = (idx & 15) * 8; if (key < nk) *(LAS v4u*)(Vr + key * SVR + d8) = vx[i]; }
    { float ss = 0.f;
#pragma unroll
      for (int ks = 0; ks < 8; ++ks)
#pragma unroll
          for (int j = 0; j < 8; ++j) { const float x = __uint_as_float((unsigned)(unsigned short)qf[ks][j] << 16); ss += x * x; }
      ss += __shfl_xor(ss, 32);
      const float rs = __builtin_amdgcn_rsqf(ss * (1.f / HD) + EPS) * (ATT_SCALE * 1.4426950408889634f); const float* qn = P.q_norm + l * HD + 8 * hh;
#pragma unroll
      for (int ks = 0; ks < 8; ++ks) { const f32x4 n0 = *(const f32x4*)(qn + 16 * ks), n1 = *(const f32x4*)(qn + 16 * ks + 4); float x[8];
#pragma unroll
          for (int j = 0; j < 8; ++j) x[j] = __uint_as_float((unsigned)(unsigned short)qf[ks][j] << 16) * rs;
          v4u w; w.x = cvt2(x[0] * n0.x, x[1] * n0.y); w.y = cvt2(x[2] * n0.z, x[3] * n0.w); w.z = cvt2(x[4] * n1.x, x[5] * n1.y); w.w = cvt2(x[6] * n1.z, x[7] * n1.w);
          qf[ks] = __builtin_bit_cast(bf16x8, w); } }
    __syncthreads();
    const int kb_hi = (nprev + 32 * sub) >> 5;
    const float LOG2E = 1.4426950408889634f;
    const float slope = exp2f(-(float)(hq + 1)) * LOG2E, sink = P.sinks[l * NAH + hq] * LOG2E;
    f32x16 sc[5]; float m = -1e30f;
#pragma unroll
    for (int j = 0; j < 5; ++j) { const int kb = kb_hi - 4 + j; sc[j] = zero16();
        if (kb >= 0) { const LAS bf16* kp = Kb + (32 * kb + cl) * SQ + 8 * hh; bf16x8 kf[8];
#pragma unroll
            for (int ks = 0; ks < 8; ++ks) kf[ks] = *(const LAS bf16x8*)(kp + 16 * ks);
            asm volatile("" ::: "memory");
#pragma unroll
            for (int ks = 0; ks < 8; ++ks) sc[j] = __builtin_amdgcn_mfma_f32_32x32x16_bf16(kf[ks], qf[ks], sc[j], 0, 0, 0); }
        const float base = slope * (float)(32 * (4 - j) + cl - 4 * hh);
#pragma unroll
        for (int reg = 0; reg < 16; ++reg) { const int kr0 = (reg & 3) + 8 * (reg >> 2), krow = kr0 + 4 * hh;
            float sv = sc[j][reg] - (base - slope * (float)kr0);
            if (j == 0) sv = krow >= cl ? sv : -1e30f;
            if (j == 4) sv = krow <= cl ? sv : -1e30f;
            if (kb < 0) sv = -1e30f;
            sc[j][reg] = sv; m = fmaxf(m, sv); } }
    m = fmaxf(m, __shfl_xor(m, 32)); m = fmaxf(m, sink);
    float sum = 0.f;
#pragma unroll
    for (int j = 0; j < 5; ++j)
#pragma unroll
        for (int reg = 0; reg < 16; ++reg) { const float p = __builtin_amdgcn_exp2f(sc[j][reg] - m); sc[j][reg] = p; sum += p; }
    sum += __shfl_xor(sum, 32);
    const float inv = __builtin_amdgcn_rcpf(sum + __builtin_amdgcn_exp2f(sink - m));
    bf16x8 pf[5][2];
#pragma unroll
    for (int j = 0; j < 5; ++j)
#pragma unroll
        for (int s2 = 0; s2 < 2; ++s2) { v4u w; w.x = cvt2(sc[j][8 * s2] * inv, sc[j][8 * s2 + 1] * inv); w.y = cvt2(sc[j][8 * s2 + 2] * inv, sc[j][8 * s2 + 3] * inv);
            w.z = cvt2(sc[j][8 * s2 + 4] * inv, sc[j][8 * s2 + 5] * inv); w.w = cvt2(sc[j][8 * s2 + 6] * inv, sc[j][8 * s2 + 7] * inv); pf[j][s2] = __builtin_bit_cast(bf16x8, w); }
    typedef short v4i16_t __attribute__((ext_vector_type(4)));
    const int trq = (lane & 15) >> 2, trp = lane & 3, trb = (lane >> 4) & 1;
#pragma unroll 1
    for (int db = 0; db < 4; ++db) { f32x16 z = zero16();
#pragma unroll
        for (int j = 0; j < 5; ++j) { const int kb = kb_hi - 4 + j;
            if (kb >= 0) { const LAS bf16* vp = Vr + (32 * kb + 4 * hh + trq) * SVR + 32 * db + 16 * trb + 4 * trp;
#pragma unroll
                for (int s2 = 0; s2 < 2; ++s2) { const v4i16_t lo = __builtin_amdgcn_ds_read_tr16_b64_v4i16((LAS v4i16_t*)(vp + 16 * s2 * SVR)), hi = __builtin_amdgcn_ds_read_tr16_b64_v4i16((LAS v4i16_t*)(vp + (16 * s2 + 8) * SVR));
                    const bf16x8 vfr = __builtin_shufflevector(lo, hi, 0, 1, 2, 3, 4, 5, 6, 7);
                    z = __builtin_amdgcn_mfma_f32_32x32x16_bf16(pf[j][s2], vfr, z, 0, 0, 0); } } }
        bf16* mp = P.MIX + (size_t)(rowb + q0 + 32 * sub) * DM + 1024 + hq * HD + 32 * db + cl;
#pragma unroll
        for (int reg = 0; reg < 16; ++reg) mp[(size_t)crow(reg, hh) * DM] = cvt1(z[reg]); }
    __syncthreads();
}

template <int MODE>
__device__ __forceinline__ void skinny_phase(const Frame& F0, int l) {
    Frame F = fresh(F0); const Ptrs P = load_ptrs();
    constexpr int K = MODE == 3 ? DFF : DM, NT = (MODE == 0 || MODE == 2) ? INW / 32 : DM / 32, KW = K / 8, NKS = KW / 16;
    const bf16* A = (MODE == 1 ? P.MIX : MODE == 3 ? P.FF : P.H) + (size_t)MP * K;
    const bf16* Bt = MODE == 0 ? wl_in(P.ws, l) : MODE == 1 ? wl_out(P.ws, l) : MODE == 2 ? wl_gu(P.ws, l) : wl_dn(P.ws, l);
    LAS float* red = (LAS float*)(F.lds + RING_OFF);
    const int cl = F.lane & 31, hh = F.lane >> 5;
    for (int it = F.G - 1 - F.bid; it < NT; it += F.G) {
        const int n0 = it * 32, brow0 = MODE == 2 ? ((n0 >> 7) * 256 + (n0 & 127)) : n0;
        const bf16* ap = A + (size_t)cl * K + F.wave * KW + 8 * hh;
        const bf16* bp = Bt + (size_t)(brow0 + cl) * K + F.wave * KW + 8 * hh;
        f32x16 acc0 = zero16(), acc1 = zero16();
        float pg[2] = {0.f, 0.f}, px[2] = {0.f, 0.f};
        if (MODE == 1 || MODE == 3) {
#pragma unroll
            for (int oo = 0; oo < 2; ++oo) { const int o = F.tid + NTHR * oo, reg = o >> 6, ln = o & 63, row = crow(reg, ln >> 5), col = n0 + (ln & 31);
                pg[oo] = P.MOD[((size_t)l * NMOD + NB + row) * MODW + (MODE == 1 ? 2 * DM : 5 * DM) + col];
                px[oo] = (MODE == 1 && l == 0) ? P.x_sample[(size_t)row * DM + col] : __uint_as_float((unsigned)P.XB[(size_t)(MP + row) * DM + col] << 16); } }
        constexpr int KB = (NKS % 22 == 0) ? 22 : 16;
        static_assert(NKS % KB == 0, "skinny: k-step batches");
#pragma unroll 1
        for (int k0 = 0; k0 < NKS; k0 += KB) { bf16x8 av[KB], bv0[KB], bv1[KB];
#pragma unroll
            for (int i = 0; i < KB; ++i) { av[i] = *(const bf16x8*)(ap + (k0 + i) * 16); bv0[i] = *(const bf16x8*)(bp + (k0 + i) * 16); if (MODE == 2) bv1[i] = *(const bf16x8*)(bp + (size_t)128 * K + (k0 + i) * 16); }
#pragma unroll
            for (int i = 0; i < KB; ++i) { asm volatile("" : "+v"(av[i]), "+v"(bv0[i])); if (MODE == 2) asm volatile("" : "+v"(bv1[i])); }
#pragma unroll
            for (int i = 0; i < KB; ++i) { acc0 = __builtin_amdgcn_mfma_f32_32x32x16_bf16(av[i], bv0[i], acc0, 0, 0, 0); if (MODE == 2) acc1 = __builtin_amdgcn_mfma_f32_32x32x16_bf16(av[i], bv1[i], acc1, 0, 0, 0); } }
#pragma unroll
        for (int reg = 0; reg < 16; ++reg) { red[(F.wave * 16 + reg) * 64 + F.lane] = acc0[reg]; if (MODE == 2) red[8192 + (F.wave * 16 + reg) * 64 + F.lane] = acc1[reg]; }
        __syncthreads();
#pragma unroll
        for (int oo = 0; oo < 2; ++oo) { const int o = F.tid + NTHR * oo, reg = o >> 6, ln = o & 63; float s0 = 0.f, s1 = 0.f;
#pragma unroll
            for (int w = 0; w < 8; ++w) { s0 += red[(w * 16 + reg) * 64 + ln]; if (MODE == 2) s1 += red[8192 + (w * 16 + reg) * 64 + ln]; }
            const int row = crow(reg, ln >> 5), col = n0 + (ln & 31);
            if (MODE == 0) P.PROJ[(size_t)(MP + row) * INW + col] = s0;
            if (MODE == 2) P.FF[(size_t)(MP + row) * DFF + col] = cvt1(siluf(s0) * s1);
            if (MODE == 1 || MODE == 3) { bf16* xp = P.XB + (size_t)(MP + row) * DM + col; const float x = px[oo] + pg[oo] * s0; *xp = cvt1(x);
                if (MODE == 3 && l == DEPTH - 1) P.out[O_YS + (size_t)row * DM + col] = x; } }
        __syncthreads();
    }
}

typedef float f32x2s __attribute__((ext_vector_type(2)));
struct AsRegs { f32x4 qx[8], kx[8], nx[8]; f32x2s vx[16], vn; };
__device__ __forceinline__ void attn_sample_load(const Frame& F, const Ptrs& P, int l, int it, AsRegs& R) {
    const int b = it >> 3, hq = it & 7, kvh = hq >> 2, row = MP + b, lane = F.lane, wave = F.wave;
    const size_t cbase = (((size_t)l * DB + b) * WIN) * 256 + kvh * HD;
    const int kq = lane >> 2, dq = lane & 3, key = 16 * wave + kq;
    const float* qp = P.PROJ + (size_t)row * INW + C_QA + hq * HD + dq * 32; const float* kp = P.cache_k + cbase + (size_t)key * 256 + dq * 32; const float* np = P.KN + (size_t)row * 256 + kvh * HD + dq * 32;
#pragma unroll
    for (int j = 0; j < 8; ++j) { R.qx[j] = *(const f32x4*)(qp + 4 * j); R.kx[j] = *(const f32x4*)(kp + 4 * j); R.nx[j] = *(const f32x4*)(np + 4 * j); }
#pragma unroll
    for (int j = 0; j < 16; ++j) R.vx[j] = *(const f32x2s*)(P.cache_v + cbase + (size_t)(16 * wave + j) * 256 + 2 * lane);
    R.vn = *(const f32x2s*)(P.PROJ + (size_t)row * INW + C_VA + kvh * HD + 2 * lane);
}
__device__ __forceinline__ void attn_sample(const Frame& F, const Ptrs& P, int l, int it, AsRegs& R) {
    const int b = it >> 3, hq = it & 7, kvh = hq >> 2, row = MP + b, lane = F.lane, wave = F.wave;
    LAS float* sc = (LAS float*)(F.lds + RING_OFF); LAS float* red = sc + 192;
    typedef float f32x2v __attribute__((ext_vector_type(2)));
    const int kq = lane >> 2, dq = lane & 3, key = 16 * wave + kq;
    f32x4 (&qx)[8] = R.qx; f32x4 (&kx)[8] = R.kx; f32x4 (&nx)[8] = R.nx; f32x2s (&vx)[16] = R.vx; const f32x2s vn = R.vn;
    const float slope = exp2f(-(float)(hq + 1)), sink = P.sinks[l * NAH + hq];
    { const float* qn = P.q_norm + l * HD + dq * 32; float ss = 0.f, dk = 0.f, dn = 0.f;
#pragma unroll
      for (int j = 0; j < 8; ++j) { const f32x4 n4 = *(const f32x4*)(qn + 4 * j); const f32x4 qq = qx[j];
          ss += (qq.x * qq.x + qq.y * qq.y) + (qq.z * qq.z + qq.w * qq.w);
          const f32x4 qs = qq * n4; dk += (qs.x * kx[j].x + qs.y * kx[j].y) + (qs.z * kx[j].z + qs.w * kx[j].w); dn += (qs.x * nx[j].x + qs.y * nx[j].y) + (qs.z * nx[j].z + qs.w * nx[j].w); }
      ss += __shfl_xor(ss, 1); ss += __shfl_xor(ss, 2); dk += __shfl_xor(dk, 1); dk += __shfl_xor(dk, 2); dn += __shfl_xor(dn, 1); dn += __shfl_xor(dn, 2);
      const float rs = __builtin_amdgcn_rsqf(ss * (1.f / HD) + EPS) * ATT_SCALE;
      if (dq == 0) sc[key] = dk * rs - slope * (float)(WIN - key);
      if (wave == 0 && lane == 0) sc[WIN] = dn * rs; }
    __syncthreads();
    const float s0 = sc[lane], s1 = sc[64 + lane], s2 = lane == 0 ? sc[WIN] : -1e30f;
    float m = fmaxf(fmaxf(s0, s1), s2);
#pragma unroll
    for (int o = 1; o < 64; o <<= 1) m = fmaxf(m, __shfl_xor(m, o));
    m = fmaxf(m, sink);
    const float inv = __builtin_amdgcn_rcpf(wave_sum(__expf(s0 - m) + __expf(s1 - m) + __expf(s2 - m)) + __expf(sink - m));
    f32x2v acc = (f32x2v){0.f, 0.f};
#pragma unroll
    for (int j = 0; j < 16; ++j) acc += vx[j] * (__expf(sc[16 * wave + j] - m) * inv);
    if (wave == 0) acc += vn * (__expf(sc[WIN] - m) * inv);
    *(LAS f32x2v*)(red + wave * HD + 2 * lane) = acc;
    __syncthreads();
    if (wave == 0) { f32x2v o = (f32x2v){0.f, 0.f};
#pragma unroll
        for (int w = 0; w < 8; ++w) o += *(const LAS f32x2v*)(red + w * HD + 2 * lane);
        *(unsigned*)(P.MIX + (size_t)row * DM + 1024 + hq * HD + 2 * lane) = cvt2(o.x, o.y); }
    __syncthreads();
}

__device__ __forceinline__ int hgrn_unit_of(int it) { const int pm = 4 * (it & 7) + (it >> 6), h = (it >> 3) & 7; return ((pm >> 3) * 8 + h) * 8 + (pm & 7); }
__device__ __forceinline__ int attn_unit_of(int it) { const int pm = 4 * (it & 7) + (it >> 6), q4 = (it >> 4) & 3, kvh = (it >> 3) & 1; return ((pm >> 3) * 32 + (pm & 7) * 4 + q4) * 2 + kvh; }
__device__ __forceinline__ void passA_phase(const Frame& F0, int l) {
    Frame F = fresh(F0);
    const Ptrs P = load_ptrs();
    for (int u = F.bid; u < 256; u += F.G) hgrn_seg<false>(F, P, l, hgrn_unit_of(u));
}
#ifndef MIXDUP
#define MIXDUP 0
#endif
#define REPM(k) for (int repm_ = 0; repm_ < (((MIXDUP) >> (k)) & 1) + 1; ++repm_)
constexpr int CW_SPLIT = 8192;
constexpr int CW_RFLAG = 131072;
__device__ __forceinline__ void split_arrive(const XcdBarrier& b, int gen) {
    asm volatile("s_waitcnt vmcnt(0)" ::: "memory");
    __syncthreads();
    if (threadIdx.x < 64) {
        unsigned rel = 0u; unsigned* ctl = b.bar - CW_BAR;
        if (threadIdx.x == 0) {
            unsigned* c = ctl + CW_SPLIT + 2048 * gen;
            __builtin_amdgcn_s_waitcnt(0);
            const unsigned nloc = b.st[0];
            if (xb_add(&c[64 * b.x], 1u) + 1u == nloc) { __builtin_amdgcn_fence(__ATOMIC_RELEASE, "agent"); asm volatile("s_waitcnt vmcnt(0)" ::: "memory"); rel = 1u; }
        }
        rel = __builtin_amdgcn_readfirstlane(rel);
        unsigned tl = threadIdx.x; asm volatile("" : "+v"(tl));
        if (rel && tl < 16) __hip_atomic_store(&ctl[CW_RFLAG + 128 * (16 * tl + b.x)], (unsigned)gen, __ATOMIC_RELAXED, __HIP_MEMORY_SCOPE_AGENT);
    }
}
__device__ __forceinline__ void split_wait(const XcdBarrier& b, int gen) {
    if (threadIdx.x < 64) {
        const unsigned mask = b.st[2];
        unsigned tl = threadIdx.x; asm volatile("" : "+v"(tl));
        if (tl < 16 && ((mask >> tl) & 1u)) { unsigned* f = b.bar - CW_BAR + CW_RFLAG + 128 * (16 * b.x + tl); XB_SPIN(xb_ld(f) < (unsigned)gen, b.bar); }
        if (threadIdx.x == 0) { __builtin_amdgcn_fence(__ATOMIC_ACQUIRE, "agent"); asm volatile("s_waitcnt vmcnt(0)" ::: "memory"); }
    }
    __syncthreads();
}
__device__ __forceinline__ void mixer_attn(const Frame& F0, int l) {
    REPM(1) { Frame F = fresh(F0); const Ptrs P = load_ptrs(); for (int it = F.bid; it < 256; it += F.G) attn_unit(F, P, l, attn_unit_of(it)); }
}
__device__ __forceinline__ void mixer_rest(const Frame& F0, int l) {
    REPM(0) { Frame F = fresh(F0); const Ptrs P = load_ptrs(); for (int it = F.bid; it < 256; it += F.G) hgrn_seg<true>(F, P, l, hgrn_unit_of(it)); }
    static_assert(DB * NAH == 256, "sample items pair up one to one");
    REPM(2) { Frame F = fresh(F0); const Ptrs P = load_ptrs(); for (int it = F.bid; it < 256; it += F.G) { AsRegs R; attn_sample_load(F, P, l, it, R); hgrn_unit(F, P, l, 32 + it); attn_sample(F, P, l, it, R); } }
}

__global__ void __launch_bounds__(NTHR, 2) fwd(Args a) {
    extern __shared__ __attribute__((aligned(16))) unsigned char lds[];
    Frame F;
    F.lds = (LAS unsigned char*)lds; F.MISC = (volatile LAS unsigned*)(F.lds + MISC_OFF);
    F.tid = threadIdx.x; F.lane = F.tid & 63; F.wave = __builtin_amdgcn_readfirstlane(F.tid >> 6); F.bid = blockIdx.x; F.G = gridDim.x;
    for (int u = F.tid; u < (LDS_BYTES - LDSCTL_OFF) / 4; u += NTHR) ((LAS unsigned*)(F.lds + LDSCTL_OFF))[u] = 0u;
    __syncthreads();
    XcdBarrier bar; bar.bar = (unsigned*)(a.ws + WS_CTL) + CW_BAR; bar.x = 0; bar.st = nullptr;
    if (a.fused) bar = xcd_barrier_post((unsigned*)(a.ws + WS_CTL) + CW_BAR, F.MISC + 8);
#ifndef DUPMASK
#define DUPMASK 0
#endif
#define IN(k) (a.ph_lo <= (k) && (k) < a.ph_hi)
#define REP(k) for (int rep_ = 0; rep_ < (((DUPMASK) >> (k)) & 1) + 1; ++rep_)
#ifdef SEAMDUP
#define SEAM() do { if (a.fused) { xcd_barrier(bar); xcd_barrier(bar); } } while (0)
#else
#define SEAM() do { if (a.fused) xcd_barrier(bar); } while (0)
#endif
    int sgen = 0;
#define SEAMF() do { if (a.fused) { ++sgen; split_arrive(bar, sgen); split_wait(bar, sgen); } } while (0)
    if (IN(0)) REP(0) { p0_prologue(F); SEAM(); }
    if (a.fused) {
        if (F.tid == 0) { unsigned m = 0u;
#pragma unroll
            for (unsigned j = 0; j < 16; ++j) if (xb_ld(&bar.bar[XB_XCNT(j)]) > 0u) m |= 1u << j;
            F.MISC[10] = m; }
        __syncthreads(); }
    for (int l = a.l_lo; l < a.l_hi; ++l) {
        if (IN(1)) REP(1) { norm_phase(F, l, 0); SEAMF(); }
        if (IN(2)) REP(2) { const Ptrs P = load_ptrs(); pg8::Gemm g{P.H, wl_in(P.ws, l), MP, INW, DM}; pg8::StaticOrder S; S.init(MP, INW, F.G, F.bid);
            pg8::EpiInProj E{(bf16*)(P.ws + WS_QL), (bf16*)(P.ws + WS_VL), (bf16*)(P.ws + WS_GL), (float*)(P.ws + WS_FR), (bf16*)(P.ws + WS_QA), (bf16*)(P.ws + WS_KA), (bf16*)(P.ws + WS_VA), P.out + O_VP + (size_t)l * NB * WIN * 256, 0};
#ifdef PROBE_VAT
            if (rep_ == 0 && ((DUPMASK >> 2) & 1)) { pg8::EpiInProj E2 = E; E2.novat = 1; pg8::gemm_phase<pg8::EpiInProj, pg8::StaticOrder, true, true>(F.lds + RING_OFF, g, S, E2); } else
#endif
#ifdef PROBE_EPI
            if (rep_ == 0 && ((DUPMASK >> 2) & 1)) { pg8::EpiProbe EP{(float*)(P.ws + WS_KN)}; pg8::gemm_phase<pg8::EpiProbe, pg8::StaticOrder, true, true>(F.lds + RING_OFF, g, S, EP); } else
#endif
            pg8::gemm_phase<pg8::EpiInProj, pg8::StaticOrder, true, true>(F.lds + RING_OFF, g, S, E); skinny_phase<0>(F, l); tr_rider(F, TR_X + l * I_L, TR_X + l * I_L + TR_S2, (MP / 256) * (INW / 256) % F.G);
            if (a.fused) { ++sgen; split_arrive(bar, sgen); cache_shift(F, l); split_wait(bar, sgen); } else cache_shift(F, l); }
        if (IN(3)) REP(3) { passA_phase(F, l); prep_phase(F, l); if (a.fused) { ++sgen; split_arrive(bar, sgen); } }
        if (IN(4)) REP(4) { mixer_attn(F, l); if (a.fused) split_wait(bar, sgen); mixer_rest(F, l); SEAMF(); }
        if (IN(5)) REP(5) { const Ptrs P = load_ptrs(); const float* modl = P.MOD + (size_t)l * NMOD * MODW; pg8::Gemm g{P.MIX, wl_out(P.ws, l), MP, DM, DM}; pg8::StaticOrder S; S.init(MP, DM, F.G, F.bid);
            pg8::EpiResidB E{l == 0 ? P.x_prompt : nullptr, P.XB, nullptr, modl + 2 * DM, MODW};

#ifdef PROBE_EPI
            if (rep_ == 0 && ((DUPMASK >> 5) & 1)) { pg8::EpiProbe EP{(float*)(P.ws + WS_KN)}; pg8::gemm_phase<pg8::EpiProbe, pg8::StaticOrder, true, true>(F.lds + RING_OFF, g, S, EP); continue; } else
#endif
            pg8::gemm_phase<pg8::EpiResidB, pg8::StaticOrder, true, true>(F.lds + RING_OFF, g, S, E); skinny_phase<1>(F, l); SEAMF(); }
        if (IN(6)) REP(6) { norm_phase(F, l, 1); SEAMF(); }
        if (IN(7)) REP(7) { const Ptrs P = load_ptrs(); pg8::Gemm g{P.H, wl_gu(P.ws, l), MP, 2 * DFF, DM}; pg8::StaticOrder S; S.init(MP, 2 * DFF, F.G, F.bid);
            pg8::EpiSwiglu E{P.FF, DFF};
            pg8::gemm_phase<pg8::EpiSwiglu, pg8::StaticOrder, true, true>(F.lds + RING_OFF, g, S, E); skinny_phase<2>(F, l); tr_rider(F, TR_X + l * I_L + TR_S2, TR_X + (l + 1) * I_L, (MP / 256) * (2 * DFF / 256) % F.G, l + 1 < DEPTH ? (l + 1) * (MODW / 64) + MOD_P0 : 0, l + 1 < DEPTH ? (l + 2) * (MODW / 64) : 0); SEAMF(); }
        if (IN(8)) REP(8) { const Ptrs P = load_ptrs(); const float* modl = P.MOD + (size_t)l * NMOD * MODW; pg8::Gemm g{P.FF, wl_dn(P.ws, l), MP, DM, DFF}; pg8::StaticOrder S; S.init(MP, DM, F.G, F.bid);
            pg8::EpiResidB E{nullptr, P.XB, l == DEPTH - 1 ? P.out : nullptr, modl + 5 * DM, MODW};

#ifdef PROBE_EPI
            if (rep_ == 0 && ((DUPMASK >> 8) & 1)) { pg8::EpiProbe EP{(float*)(P.ws + WS_KN)}; pg8::gemm_phase<pg8::EpiProbe, pg8::StaticOrder, true, true>(F.lds + RING_OFF, g, S, EP); continue; } else
#endif
            pg8::gemm_phase<pg8::EpiResidB, pg8::StaticOrder, true, true>(F.lds + RING_OFF, g, S, E); skinny_phase<3>(F, l); if (l + 1 < a.l_hi) SEAMF(); }
    }
#undef IN
#undef SEAM
}

#ifndef MK_FUSED
#define MK_FUSED 1
#endif
extern "C" void kernel_launch(void* const* d_in, const int* in_sizes, int n_in, void* d_out, int out_size, void* d_ws, size_t ws_size, hipStream_t stream) {
    static int grid = 0;
    if (grid == 0) {
        if (n_in != 21 || (size_t)out_size != O_END || ws_size < WS_END) { fprintf(stderr, "kernel_launch: unexpected shapes: n_in %d out %d (want %zu) ws %zu (want %zu)\n", n_in, out_size, (size_t)O_END, ws_size, (size_t)WS_END); grid = -1; return; }
        int dev = 0, cus = 0, per_cu = 0;
        if (hipGetDevice(&dev) != hipSuccess || hipDeviceGetAttribute(&cus, hipDeviceAttributeMultiprocessorCount, dev) != hipSuccess) { grid = -1; return; }
        if (hipFuncSetAttribute((const void*)fwd, hipFuncAttributeMaxDynamicSharedMemorySize, LDS_BYTES) != hipSuccess) { fprintf(stderr, "kernel_launch: hipFuncSetAttribute failed\n"); grid = -1; return; }
        if (hipOccupancyMaxActiveBlocksPerMultiprocessor(&per_cu, (const void*)fwd, NTHR, LDS_BYTES) != hipSuccess || per_cu < 1) fprintf(stderr, "kernel_launch: occupancy query says %d\n", per_cu);
        (void)hipGetLastError();
        grid = cus;
    }
    if (grid < 0) return;
    if (hipMemsetAsync((char*)d_ws + WS_CTL, 0, CTL_ZERO_BYTES, stream) != hipSuccess) return;
    Args a{};
    for (int i = 0; i < 21; ++i) a.in[i] = (const float*)d_in[i];
    a.out = (float*)d_out; a.ws = (unsigned char*)d_ws;
#if MK_FUSED
    a.l_lo = 0; a.l_hi = DEPTH; a.ph_lo = 0; a.ph_hi = 9; a.fused = 1;
    hipLaunchKernelGGL(fwd, dim3(grid), dim3(NTHR), LDS_BYTES, stream, a);
#else
    a.fused = 0;
    a.l_lo = 0; a.l_hi = 0; a.ph_lo = 0; a.ph_hi = 1;
    hipLaunchKernelGGL(fwd, dim3(grid), dim3(NTHR), LDS_BYTES, stream, a);
    for (int l = 0; l < DEPTH; ++l) for (int ph = 1; ph <= 8; ++ph) { a.l_lo = l; a.l_hi = l + 1; a.ph_lo = ph; a.ph_hi = ph + 1; hipLaunchKernelGGL(fwd, dim3(grid), dim3(NTHR), LDS_BYTES, stream, a); }
#endif
}
```
